# Optimizing an MI355X kernel written in HIP

```python
import math
import jax, jax.numpy as jnp
from jax import lax
import numpy as np

D_MODEL = 2048
BATCH = 4
SEQ = 8192
DEPTH = 4

HEAD_DIM = 128
FOX_HEADS = 8
DIL_PATTERNS = ((128, 1), (512, 4), (2048, 16))
DIL_HEADS_PER_GROUP = 4
DIL_HEADS = DIL_HEADS_PER_GROUP * len(DIL_PATTERNS)
D_FF = 5632
PLE_DIM = 256
ROPE_THETA = 10000.0
RMS_EPS = 1e-6
Q_BLOCK = 128
N_NORMS = 8
FOX_W = FOX_HEADS * HEAD_DIM
DIL_W = DIL_HEADS * HEAD_DIM
DIL_OUT_W = DIL_HEADS_PER_GROUP * HEAD_DIM
N_COLS = 3 * FOX_W + FOX_HEADS + 3 * DIL_W + 2 * D_MODEL

kernel_name = "fox_dilated_gated_hybrid_trunk"


def rms_norm(x, g):
    xf = x.astype(jnp.float32)
    y = xf * lax.rsqrt(jnp.mean(xf * xf, axis=-1, keepdims=True) + RMS_EPS)
    return (y * g.astype(jnp.float32)).astype(x.dtype)


def swiglu(u, w_in, w_out):
    a, b = jnp.split(u @ w_in, 2, axis=-1)
    return (jax.nn.silu(a) * b) @ w_out


def split_heads(t, n_heads):
    B, S, _ = t.shape
    return t.reshape(B, S, n_heads, HEAD_DIM).transpose(0, 2, 1, 3)


def merge_heads(t):
    B, H, S, hd = t.shape
    return t.transpose(0, 2, 1, 3).reshape(B, S, H * hd)


def rope(x, pos):
    half = HEAD_DIM // 2
    inv = ROPE_THETA ** (-jnp.arange(half, dtype=jnp.float32) * 2.0 / HEAD_DIM)
    ang = pos[:, None] * inv[None, :]
    cos = jnp.cos(ang).astype(x.dtype)
    sin = jnp.sin(ang).astype(x.dtype)
    x1, x2 = x[..., :half], x[..., half:]
    return jnp.concatenate([x1 * cos - x2 * sin, x2 * cos + x1 * sin], axis=-1)


def fox_attention(q, k, v, log_f):
    B, H, S, hd = q.shape
    nb = S // Q_BLOCK
    c = jnp.cumsum(log_f.astype(jnp.float32), axis=-1)
    q_blocks = q.reshape(B, H, nb, Q_BLOCK, hd).transpose(2, 0, 1, 3, 4)
    c_blocks = c.reshape(B, H, nb, Q_BLOCK).transpose(2, 0, 1, 3)
    key_pos = jnp.arange(S)
    scale = hd ** -0.5

    def block(args):
        q_i, c_i, i = args
        s = jnp.einsum('bhqd,bhkd->bhqk', q_i, k).astype(jnp.float32) * scale
        s = s + c_i[..., None] - c[:, :, None, :]
        q_pos = i * Q_BLOCK + jnp.arange(Q_BLOCK)
        s = jnp.where(q_pos[:, None] >= key_pos[None, :], s, -jnp.inf)
        p = jax.nn.softmax(s, axis=-1)
        return jnp.einsum('bhqk,bhkd->bhqd', p.astype(v.dtype), v)

    o = lax.map(block, (q_blocks, c_blocks, jnp.arange(nb)))
    return o.transpose(1, 2, 0, 3, 4).reshape(B, H, S, hd)


def dilated_group_attention(q, k, v, window, dilation):
    B, H, S, hd = q.shape
    L = S // dilation
    nk = window // dilation
    nb = -(-L // nk)
    Lp = nb * nk

    def by_residue(t):
        return t.reshape(B, H, L, dilation, hd).transpose(0, 1, 3, 2, 4)

    qs = jnp.pad(by_residue(q), ((0, 0), (0, 0), (0, 0), (0, Lp - L), (0, 0)))
    qs = qs.reshape(B, H, dilation, nb, nk, hd)

    def band(t):
        tp = jnp.pad(by_residue(t), ((0, 0), (0, 0), (0, 0), (nk, Lp - L), (0, 0)))
        prev = tp[..., :Lp, :].reshape(B, H, dilation, nb, nk, hd)
        cur = tp[..., nk:, :].reshape(B, H, dilation, nb, nk, hd)
        return jnp.concatenate([prev, cur], axis=-2)

    kb, vb = band(k), band(v)
    s = jnp.einsum('bhrnqd,bhrnkd->bhrnqk', qs, kb).astype(jnp.float32) * (hd ** -0.5)
    qi = jnp.arange(nk)[:, None]
    ki = jnp.arange(2 * nk)[None, :]
    dist = qi + nk - ki
    blk = jnp.arange(nb)[:, None, None]
    valid = (dist >= 0) & (dist <= nk) & (blk * nk - nk + ki >= 0)
    s = jnp.where(valid, s, -jnp.inf)
    lse = jax.nn.logsumexp(s, axis=-1)
    p = jnp.exp(s - lse[..., None])
    o = jnp.einsum('bhrnqk,bhrnkd->bhrnqd', p.astype(vb.dtype), vb)
    o = o.reshape(B, H, dilation, Lp, hd)[..., :L, :].transpose(0, 1, 3, 2, 4).reshape(B, H, S, hd)
    lse = lse.reshape(B, H, dilation, Lp)[..., :L].transpose(0, 1, 3, 2).reshape(B, H, S)
    return o, lse


def token_mixer(u, w_in, b_f, w_br_a, w_br_b, w_out):
    B, S, _ = u.shape
    sizes = (FOX_W, FOX_W, FOX_W, FOX_HEADS, DIL_W, DIL_W, DIL_W, D_MODEL, D_MODEL)
    offsets = [int(o) for o in np.cumsum(sizes)[:-1]]
    z = u @ w_in
    q_a, k_a, v_a, f_a, q_b, k_b, v_b, g_a, g_b = jnp.split(z, offsets, axis=-1)

    log_f = jax.nn.log_sigmoid((f_a + b_f).astype(jnp.float32)).transpose(0, 2, 1)
    o_a = fox_attention(split_heads(q_a, FOX_HEADS), split_heads(k_a, FOX_HEADS),
                        split_heads(v_a, FOX_HEADS), log_f)
    y_a = merge_heads(o_a) @ w_br_a

    pos = jnp.arange(S, dtype=jnp.float32)
    qb = rope(split_heads(q_b, DIL_HEADS), pos)
    kb = rope(split_heads(k_b, DIL_HEADS), pos)
    vb = split_heads(v_b, DIL_HEADS)
    outs, lses = [], []
    for g, (window, dilation) in enumerate(DIL_PATTERNS):
        sl = slice(g * DIL_HEADS_PER_GROUP, (g + 1) * DIL_HEADS_PER_GROUP)
        o_g, lse_g = dilated_group_attention(qb[:, sl], kb[:, sl], vb[:, sl], window, dilation)
        outs.append(o_g)
        lses.append(lse_g)
    w_g = jax.nn.softmax(jnp.stack(lses, axis=0), axis=0)
    o_b = jnp.sum(w_g[..., None].astype(vb.dtype) * jnp.stack(outs, axis=0), axis=0)
    y_b = merge_heads(o_b) @ w_br_b

    merged = jax.nn.sigmoid(g_a) * y_a + jax.nn.sigmoid(g_b) * y_b
    return merged @ w_out


def setup_inputs(seed: int = 0) -> dict:
    key = jax.random.key(seed)
    ks = jax.random.split(key, 16)

    def w(k, shape, fan_in):
        return jax.random.normal(k, shape, jnp.float32) * (fan_in ** -0.5)

    return {
        "x": jax.random.normal(ks[0], (BATCH, SEQ, D_MODEL), jnp.float32),
        "p": jax.random.normal(ks[1], (DEPTH, BATCH, SEQ, PLE_DIM), jnp.float32),
        "norm_g": 1.0 + 0.05 * jax.random.normal(ks[2], (DEPTH, N_NORMS, D_MODEL), jnp.float32),
        "ffn1_w_in": w(ks[3], (DEPTH, D_MODEL, 2 * D_FF), D_MODEL),
        "ffn1_w_out": w(ks[4], (DEPTH, D_FF, D_MODEL), D_FF),
        "mix_w_in": w(ks[5], (DEPTH, D_MODEL, N_COLS), D_MODEL),
        "fox_b_f": jax.random.uniform(ks[6], (DEPTH, FOX_HEADS), jnp.float32, 1.0, 4.0),
        "mix_w_br_a": w(ks[7], (DEPTH, FOX_W, D_MODEL), FOX_W),
        "mix_w_br_b": w(ks[8], (DEPTH, DIL_OUT_W, D_MODEL), DIL_OUT_W),
        "mix_w_out": w(ks[9], (DEPTH, D_MODEL, D_MODEL), D_MODEL),
        "ffn2_w_in": w(ks[10], (DEPTH, D_MODEL, 2 * D_FF), D_MODEL),
        "ffn2_w_out": w(ks[11], (DEPTH, D_FF, D_MODEL), D_FF),
        "ple_w_proj": w(ks[12], (DEPTH, PLE_DIM, D_MODEL), PLE_DIM),
        "ple_w_gate": w(ks[13], (DEPTH, D_MODEL, D_MODEL), D_MODEL),
    }


def reference(x, p, norm_g, ffn1_w_in, ffn1_w_out, mix_w_in, fox_b_f, mix_w_br_a,
              mix_w_br_b, mix_w_out, ffn2_w_in, ffn2_w_out, ple_w_proj, ple_w_gate):
    for i in range(DEPTH):
        g = norm_g[i]
        x = x + 0.5 * rms_norm(swiglu(rms_norm(x, g[0]), ffn1_w_in[i], ffn1_w_out[i]), g[1])
        y = token_mixer(rms_norm(x, g[2]), mix_w_in[i], fox_b_f[i], mix_w_br_a[i],
                        mix_w_br_b[i], mix_w_out[i])
        x = x + rms_norm(y, g[3])
        x = x + 0.5 * rms_norm(swiglu(rms_norm(x, g[4]), ffn2_w_in[i], ffn2_w_out[i]), g[5])
        e = p[i] @ ple_w_proj[i]
        gate = jax.nn.sigmoid(rms_norm(x, g[6]) @ ple_w_gate[i])
        x = x + rms_norm(gate * e, g[7])
    return x
```

```cpp
#include <hip/hip_runtime.h>
#include <cstdio>
#include <cstdint>

constexpr int DM = 2048, NBATCH = 4, SEQ = 8192, DEPTH = 4, HD = 128, FOXH = 8, DILH = 12, DFF = 5632, PLE = 256;
constexpr int M = NBATCH * SEQ;
constexpr int NCOLS = 11784;
constexpr int C_F = 3072, C_QB = 3080, C_GA = 7688;
constexpr float RMS_EPS = 1e-6f;
constexpr float ATT_SCALE = 0.08838834764831845f;

#ifndef MK_BRINGUP
#define MK_BRINGUP 1
#endif
namespace pg8 {
#define PG8_LAS __attribute__((address_space(3)))
typedef unsigned short bf16_t;
typedef short bf16x8 __attribute__((ext_vector_type(8)));
typedef float f32x4 __attribute__((ext_vector_type(4)));
typedef unsigned u32x4 __attribute__((ext_vector_type(4)));
constexpr int BM = 256, BK = 64, HALF = 128, HTB = HALF * BK * 2  , STAGE_BYTES = 8 * HTB, NXCD = 8, WGM = 8;

__host__ __device__ __forceinline__ int lds_byte(int r, int c) { const int st = (r >> 4) * 2 + (c >> 5), rr = r & 15, cc = c & 31, ob = rr * 64 + cc * 2; return st * 1024 + (ob ^ (((ob >> 9) & 1) << 5)); }
__host__ __device__ __forceinline__ void stage_rc(int b, int& R, int& C) { const int st = b / 1024, sb = b % 1024, swz = sb ^ (((sb >> 9) & 1) << 5); R = (st >> 1) * 16 + swz / 64; C = (st & 1) * 32 + (swz % 64) / 2; }
__host__ __device__ __forceinline__ int perm32(int rho) { const int n = rho >> 4, i = rho & 15; return 8 * (i >> 2) + 4 * n + (i & 3); }

struct Unit { int pm, pn; };
struct Gemm { const bf16_t* A; const bf16_t* Bt; int M, N, K; };

struct StaticOrder {
    int nM, nN, nwg, G, c;
    __host__ __device__ void init(int M, int N, int G_, int c_) { nM = M / BM; nN = N / BM; nwg = nM * nN; G = G_; c = c_; }
    __host__ __device__ bool next(int i, Unit& u) const {
        const long L = (long)i * G + c; if (L >= nwg) return false;
        int wgid = (int)L; { const int q = nwg / NXCD, r = nwg % NXCD, xcd = wgid % NXCD, off = wgid / NXCD; wgid = (xcd < r ? xcd * (q + 1) : r * (q + 1) + (xcd - r) * q) + off; }
        const int nig = WGM * nN, gid = wgid / nig, fm = gid * WGM, gsz = (nM - fm) < WGM ? (nM - fm) : WGM;
        u.pm = fm + ((wgid % nig) % gsz); u.pn = (wgid % nig) / gsz; return true;
    }
    __device__ __forceinline__ void a_ready(const Unit&) const {}
    __device__ __forceinline__ void done(const Unit&) const {}
};

typedef __bf16 bf16x2_hw __attribute__((ext_vector_type(2)));
typedef float f32x2_hw __attribute__((ext_vector_type(2)));
__device__ __forceinline__ unsigned cvt_pk_bf16(float lo, float hi) { const f32x2_hw v = {lo, hi}; const bf16x2_hw r = __builtin_convertvector(v, bf16x2_hw); return __builtin_bit_cast(unsigned, r); }
typedef float f32x2 __attribute__((ext_vector_type(2)));
__device__ __forceinline__ float sigmoidf_(float v) { return __builtin_amdgcn_rcpf(1.0f + __builtin_amdgcn_exp2f(-1.4426950408889634f * v)); }
__device__ __forceinline__ f32x4 sigmoid4(f32x4 v) { return (f32x4){sigmoidf_(v[0]), sigmoidf_(v[1]), sigmoidf_(v[2]), sigmoidf_(v[3])}; }
__device__ __forceinline__ u32x4 pack8(f32x4 v0, f32x4 v1) { u32x4 w; w.x = cvt_pk_bf16(v0[0], v0[1]); w.y = cvt_pk_bf16(v0[2], v0[3]); w.z = cvt_pk_bf16(v1[0], v1[1]); w.w = cvt_pk_bf16(v1[2], v1[3]); return w; }
__device__ __forceinline__ void unpack8(u32x4 w, f32x4& v0, f32x4& v1) {
    v0 = (f32x4){__uint_as_float(w.x << 16), __uint_as_float(w.x & 0xffff0000u), __uint_as_float(w.y << 16), __uint_as_float(w.y & 0xffff0000u)};
    v1 = (f32x4){__uint_as_float(w.z << 16), __uint_as_float(w.z & 0xffff0000u), __uint_as_float(w.w << 16), __uint_as_float(w.w & 0xffff0000u)}; }

template <int ACT  > struct EpiSplitBf16 {
    static constexpr bool PERM = true, AFTER_DRAIN = false;
    bf16_t* O; int ldc; int split_cols; size_t split_stride;
    __device__ __forceinline__ void operator()(const f32x4 (&acc)[2][2][4][2], const Unit& u, int wr, int wc, int fr, int fq) const {
        const int row0 = u.pm * BM + wr * 64 + fr; int colt = u.pn * BM; bf16_t* base = O;
        if (split_cols) { const int t = colt / split_cols; base += (size_t)t * split_stride; colt -= t * split_cols; }
        const int col0 = colt + wc * 32 + 8 * fq;
#pragma unroll
        for (int ai = 0; ai < 2; ++ai)
#pragma unroll
            for (int m = 0; m < 4; ++m) { bf16_t* rowp = base + (size_t)(row0 + ai * HALF + m * 16) * ldc + col0;
#pragma unroll
                for (int bj = 0; bj < 2; ++bj) { f32x4 v0 = acc[ai][bj][m][0], v1 = acc[ai][bj][m][1];
                    if (ACT == 1) { v0 = sigmoid4(v0); v1 = sigmoid4(v1); }
                    *(u32x4*)(rowp + bj * HALF) = pack8(v0, v1); } }
    }
};
struct EpiSwiGLU {
    static constexpr bool PERM = true, AFTER_DRAIN = false;
    bf16_t* H; int ldc;
    __device__ __forceinline__ void operator()(const f32x4 (&acc)[2][2][4][2], const Unit& u, int wr, int wc, int fr, int fq) const {
        const int row0 = u.pm * BM + wr * 64 + fr, col0 = u.pn * HALF + wc * 32 + 8 * fq;
#pragma unroll
        for (int ai = 0; ai < 2; ++ai)
#pragma unroll
            for (int m = 0; m < 4; ++m) { bf16_t* rowp = H + (size_t)(row0 + ai * HALF + m * 16) * ldc + col0;
                const f32x4 a0 = acc[ai][0][m][0], a1 = acc[ai][0][m][1], b0 = acc[ai][1][m][0], b1 = acc[ai][1][m][1];
                const f32x4 v0 = a0 * sigmoid4(a0) * b0, v1 = a1 * sigmoid4(a1) * b1;
                *(u32x4*)rowp = pack8(v0, v1); }
    }
};
struct EpiRope {
    static constexpr bool PERM = true, AFTER_DRAIN = false;
    bf16_t* QB; bf16_t* KB; const float* cosT; const float* sinT;
    __device__ __forceinline__ void operator()(const f32x4 (&acc)[2][2][4][2], const Unit& u, int wr, int wc, int fr, int fq) const {
        const int row0 = u.pm * BM + wr * 64 + fr; const int tsel = u.pn / 6, pnl = u.pn - tsel * 6;
        bf16_t* base = tsel ? KB : QB; const int dd0 = 32 * (wc & 1) + 8 * fq, head = 2 * pnl + (wc >> 1);
#pragma unroll
        for (int ai = 0; ai < 2; ++ai)
#pragma unroll
            for (int m = 0; m < 4; ++m) { const int row = row0 + ai * HALF + m * 16, pos = row & (SEQ - 1);
                const f32x4 c0 = *(const f32x4*)(cosT + pos * 64 + dd0), c1 = *(const f32x4*)(cosT + pos * 64 + dd0 + 4);
                const f32x4 s0 = *(const f32x4*)(sinT + pos * 64 + dd0), s1 = *(const f32x4*)(sinT + pos * 64 + dd0 + 4);
                const f32x4 x10 = acc[ai][0][m][0], x11 = acc[ai][0][m][1], x20 = acc[ai][1][m][0], x21 = acc[ai][1][m][1];
                bf16_t* rowp = base + (size_t)row * 1536 + head * 128 + dd0;
                *(u32x4*)rowp = pack8(x10 * c0 - x20 * s0, x11 * c1 - x21 * s1);
                *(u32x4*)(rowp + 64) = pack8(x20 * c0 + x10 * s0, x21 * c1 + x11 * s1);
                asm volatile("" ::: "memory"); }
    }
};
template <int MODE> struct EpiGate {
    static constexpr bool PERM = true, AFTER_DRAIN = false;
    const bf16_t* G; bf16_t* T;
    __device__ __forceinline__ void operator()(const f32x4 (&acc)[2][2][4][2], const Unit& u, int wr, int wc, int fr, int fq) const {
        const int row0 = u.pm * BM + wr * 64 + fr, col0 = u.pn * BM + wc * 32 + 8 * fq;
#pragma unroll
        for (int ai = 0; ai < 2; ++ai)
#pragma unroll
            for (int m = 0; m < 4; ++m) { const size_t off = (size_t)(row0 + ai * HALF + m * 16) * 2048 + col0;
#pragma unroll
                for (int bj = 0; bj < 2; ++bj) { f32x4 g0, g1; unpack8(*(const u32x4*)(G + off + bj * HALF), g0, g1);
                    f32x4 v0 = g0 * acc[ai][bj][m][0], v1 = g1 * acc[ai][bj][m][1];
                    if (MODE == 1) { f32x4 t0, t1; unpack8(*(const u32x4*)(T + off + bj * HALF), t0, t1); v0 += t0; v1 += t1; }
                    *(u32x4*)(T + off + bj * HALF) = pack8(v0, v1); }
                asm volatile("" ::: "memory"); }
    }
};
template <int MODE> struct EpiF32 {
    static constexpr bool PERM = false, AFTER_DRAIN = false;
    float* C; int ldc;
    __device__ __forceinline__ void operator()(const f32x4 (&acc)[2][2][4][2], const Unit& u, int wr, int wc, int fr, int fq) const {
        const int row0 = u.pm * BM + wr * 64 + fr, col0 = u.pn * BM + wc * 32 + 4 * fq;
#pragma unroll
        for (int ai = 0; ai < 2; ++ai)
#pragma unroll
            for (int m = 0; m < 4; ++m) { float* rowp = C + (size_t)(row0 + ai * HALF + m * 16) * ldc + col0;
#pragma unroll
                for (int bj = 0; bj < 2; ++bj)
#pragma unroll
                    for (int n = 0; n < 2; ++n) { f32x4 v = acc[ai][bj][m][n];
                        if (MODE == 1) { v = sigmoid4(v) * *(const f32x4*)(rowp + bj * HALF + n * 16); }
                        *(f32x4*)(rowp + bj * HALF + n * 16) = v; }
                if (MODE == 1) asm volatile("" ::: "memory"); }
    }
};

template <class Epi, class Sched, bool ALIGN_EPI = false, bool SP2 = false>
__device__ __forceinline__ void gemm_phase(PG8_LAS unsigned char* lds, const Gemm g, const Sched& S, const Epi& E) {
    int tid_ = threadIdx.x; asm volatile("" : "+v"(tid_));
    const int tid = tid_, wid = __builtin_amdgcn_readfirstlane(tid >> 6), lane = tid & 63, wr = wid >> 2, wc = wid & 3, fr = lane & 15, fq = lane >> 4;
    const int K = g.K, nt = K / BK;
    unsigned voffA[2], voffB[2];
#pragma unroll
    for (int i = 0; i < 2; ++i) { int R, C; stage_rc(tid * 16 + i * 8192, R, C); const int Rb = Epi::PERM ? ((R & ~31) + perm32(R & 31)) : R;
        voffA[i] = (unsigned)(R * K + C) * 2u; voffB[i] = (unsigned)(Rb * K + C) * 2u; }
    const size_t kstep = (size_t)(BK * 2);
    const size_t hstep = (size_t)HALF * K * 2;
    const size_t tstep = 2 * hstep;
    const unsigned ldsw = (unsigned)wid * 1024u;
    const int aoff = lds_byte(wr * 64 + fr, fq * 8), boff = lds_byte(wc * 32 + fr, fq * 8);
#define PG8_SA(b, h) (((b) * 2 + (h)) * HTB)
#define PG8_SB(b, h) ((4 + (b) * 2 + (h)) * HTB)
#define PG8_STAGE(bufoff, gbase, voff) do { _Pragma("unroll") for (int _i = 0; _i < 2; ++_i) \
        __builtin_amdgcn_global_load_lds((const unsigned*)((const char*)(gbase) + (voff)[_i]), (PG8_LAS unsigned*)(lds + (bufoff) + ldsw + _i * 8192), 16, 0, 0); } while (0)
#define PG8_LDA(dst, b, h) do { _Pragma("unroll") for (int m = 0; m < 4; ++m) _Pragma("unroll") for (int k = 0; k < 2; ++k) dst[m][k] = *(const PG8_LAS bf16x8*)(lds + PG8_SA(b, h) + aoff + m * 2048 + k * 1024); } while (0)
#define PG8_LDB(dst, b, h) do { _Pragma("unroll") for (int n = 0; n < 2; ++n) _Pragma("unroll") for (int k = 0; k < 2; ++k) dst[n][k] = *(const PG8_LAS bf16x8*)(lds + PG8_SB(b, h) + boff + n * 2048 + k * 1024); } while (0)
#define PG8_MMA(ai, bj, At, Bt) do { __builtin_amdgcn_s_setprio(1); _Pragma("unroll") for (int m = 0; m < 4; ++m) _Pragma("unroll") for (int n = 0; n < 2; ++n) _Pragma("unroll") for (int k = 0; k < 2; ++k) \
        acc[ai][bj][m][n] = __builtin_amdgcn_mfma_f32_16x16x32_bf16(Bt[n][k], At[m][k], acc[ai][bj][m][n], 0, 0, 0); __builtin_amdgcn_s_setprio(0); } while (0)
#define PG8_WAIT_V(n) asm volatile("s_waitcnt vmcnt(" #n ")" ::: "memory")
#define PG8_WAIT_L(n) asm volatile("s_waitcnt lgkmcnt(" #n ")" ::: "memory")
#define PG8_BAR __builtin_amdgcn_s_barrier()
#define PG8_SCHED __builtin_amdgcn_sched_barrier(0)
    Unit cur, nxt; int ui = 0;
    if (!S.next(0, cur)) return;
    f32x4 acc[2][2][4][2];
#pragma unroll
    for (int a = 0; a < 2; ++a)
#pragma unroll
        for (int b = 0; b < 2; ++b)
#pragma unroll
            for (int m = 0; m < 4; ++m)
#pragma unroll
                for (int n = 0; n < 2; ++n) acc[a][b][m][n] = (f32x4){0.f, 0.f, 0.f, 0.f};
    bf16x8 At[4][2], B0[2][2], B1[2][2];
    const char* cA = (const char*)g.A + (size_t)cur.pm * tstep; const char* cB = (const char*)g.Bt + (size_t)cur.pn * tstep;
    S.a_ready(cur);
    if constexpr (SP2) {
        PG8_STAGE(PG8_SB(0, 0), cB, voffB); PG8_STAGE(PG8_SB(0, 1), cB + hstep, voffB); PG8_STAGE(PG8_SA(0, 0), cA, voffA); PG8_STAGE(PG8_SA(0, 1), cA + hstep, voffA);
        if (wr == 1) PG8_BAR;
        PG8_WAIT_V(2); PG8_BAR;
        PG8_STAGE(PG8_SB(1, 0), cB + kstep, voffB); PG8_STAGE(PG8_SA(1, 0), cA + kstep, voffA); PG8_STAGE(PG8_SB(1, 1), cB + hstep + kstep, voffB);
        PG8_WAIT_V(6); PG8_BAR;
    } else {
        PG8_STAGE(PG8_SB(0, 0), cB, voffB); PG8_STAGE(PG8_SA(0, 0), cA, voffA); PG8_STAGE(PG8_SB(0, 1), cB + hstep, voffB); PG8_STAGE(PG8_SA(0, 1), cA + hstep, voffA);
        if (wr == 1) PG8_BAR;
        PG8_WAIT_V(4); PG8_BAR;
        PG8_STAGE(PG8_SB(1, 0), cB + kstep, voffB); PG8_STAGE(PG8_SA(1, 0), cA + kstep, voffA); PG8_STAGE(PG8_SB(1, 1), cB + hstep + kstep, voffB);
        PG8_WAIT_V(6); PG8_BAR;
    }
    for (;;) {
        const bool has_next = S.next(ui + 1, nxt);
        const char* nA = has_next ? (const char*)g.A + (size_t)nxt.pm * tstep : cA; const char* nB = has_next ? (const char*)g.Bt + (size_t)nxt.pn * tstep : cB;
        for (int t = 0; t < nt; t += 2) {
            const bool last = (t == nt - 2);
            const char* a1 = cA + (size_t)(t + 1) * kstep;
            const char* a2 = last ? nA : cA + (size_t)(t + 2) * kstep; const char* b2 = last ? nB : cB + (size_t)(t + 2) * kstep;
            const char* a3 = a2 + kstep; const char* b3 = b2 + kstep;
            if (last && has_next) S.a_ready(nxt);
            if constexpr (SP2) {
            PG8_LDB(B0, 0, 0); PG8_LDB(B1, 0, 1); PG8_SCHED; PG8_LDA(At, 0, 0); PG8_STAGE(PG8_SA(1, 1), a1 + hstep, voffA);
            PG8_WAIT_V(8); PG8_WAIT_L(0); PG8_BAR; PG8_MMA(0, 0, At, B0); PG8_MMA(0, 1, At, B1); PG8_BAR; PG8_SCHED;
            PG8_LDA(At, 0, 1); PG8_STAGE(PG8_SB(0, 0), b2, voffB); PG8_STAGE(PG8_SB(0, 1), b2 + hstep, voffB); PG8_STAGE(PG8_SA(0, 0), a2, voffA);
            PG8_WAIT_V(8); PG8_WAIT_L(0); PG8_BAR; PG8_MMA(1, 0, At, B0); PG8_MMA(1, 1, At, B1); PG8_BAR; PG8_SCHED;
            PG8_LDB(B0, 1, 0); PG8_LDB(B1, 1, 1); PG8_SCHED; PG8_LDA(At, 1, 0); PG8_STAGE(PG8_SA(0, 1), a2 + hstep, voffA);
            PG8_WAIT_V(8); PG8_WAIT_L(0); PG8_BAR; PG8_MMA(0, 0, At, B0); PG8_MMA(0, 1, At, B1); PG8_BAR; PG8_SCHED;
            PG8_LDA(At, 1, 1); PG8_STAGE(PG8_SB(1, 0), b3, voffB); PG8_STAGE(PG8_SB(1, 1), b3 + hstep, voffB); PG8_STAGE(PG8_SA(1, 0), a3, voffA);
            PG8_WAIT_V(8); PG8_WAIT_L(0); PG8_BAR; PG8_MMA(1, 0, At, B0); PG8_MMA(1, 1, At, B1); PG8_BAR; PG8_SCHED;
            } else {
            PG8_LDB(B0, 0, 0); PG8_SCHED; PG8_LDA(At, 0, 0); PG8_STAGE(PG8_SA(1, 1), a1 + hstep, voffA);
            PG8_WAIT_L(8); PG8_BAR; PG8_WAIT_L(0); PG8_MMA(0, 0, At, B0); PG8_BAR; PG8_SCHED;
            PG8_LDB(B1, 0, 1); PG8_STAGE(PG8_SB(0, 0), b2, voffB);
            PG8_BAR; PG8_WAIT_L(0); PG8_MMA(0, 1, At, B1); PG8_BAR;
            PG8_LDA(At, 0, 1); PG8_STAGE(PG8_SA(0, 0), a2, voffA);
            PG8_BAR; PG8_WAIT_L(0); PG8_MMA(1, 0, At, B0); PG8_BAR; PG8_SCHED;
            PG8_STAGE(PG8_SB(0, 1), b2 + hstep, voffB);
            PG8_WAIT_V(6); PG8_BAR; PG8_MMA(1, 1, At, B1); PG8_BAR;
            PG8_LDB(B0, 1, 0); PG8_SCHED; PG8_LDA(At, 1, 0); PG8_STAGE(PG8_SA(0, 1), a2 + hstep, voffA);
            PG8_WAIT_L(8); PG8_BAR; PG8_WAIT_L(0); PG8_MMA(0, 0, At, B0); PG8_BAR; PG8_SCHED;
            PG8_LDB(B1, 1, 1); PG8_STAGE(PG8_SB(1, 0), b3, voffB);
            PG8_BAR; PG8_WAIT_L(0); PG8_MMA(0, 1, At, B1); PG8_BAR;
            PG8_LDA(At, 1, 1); PG8_STAGE(PG8_SA(1, 0), a3, voffA);
            PG8_BAR; PG8_WAIT_L(0); PG8_MMA(1, 0, At, B0); PG8_BAR; PG8_SCHED;
            PG8_STAGE(PG8_SB(1, 1), b3 + hstep, voffB);
            PG8_WAIT_V(6); PG8_BAR; PG8_MMA(1, 1, At, B1); PG8_BAR;
            }
        }
        if constexpr (ALIGN_EPI) { if (wr == 0) PG8_BAR; }
        if constexpr (!Epi::AFTER_DRAIN) { E(acc, cur, wr, wc, fr, fq); S.done(cur); }
        if (!has_next) break;
#pragma unroll
        for (int a = 0; a < 2; ++a)
#pragma unroll
            for (int b = 0; b < 2; ++b)
#pragma unroll
                for (int m = 0; m < 4; ++m)
#pragma unroll
                    for (int n = 0; n < 2; ++n) acc[a][b][m][n] = (f32x4){0.f, 0.f, 0.f, 0.f};
        cur = nxt; cA = nA; cB = nB; ++ui;
        if constexpr (ALIGN_EPI) { if (wr == 1) PG8_BAR; }
    }
    PG8_WAIT_V(0);
    if constexpr (!ALIGN_EPI) { if (wr == 0) PG8_BAR; }
    PG8_BAR;
    if constexpr (Epi::AFTER_DRAIN) { E.fused(acc, cur, wr, wc, fr, fq, lds, wid, lane); S.done(cur); }
#undef PG8_SA
#undef PG8_SB
#undef PG8_STAGE
#undef PG8_LDA
#undef PG8_LDB
#undef PG8_MMA
#undef PG8_WAIT_V
#undef PG8_WAIT_L
#undef PG8_BAR
#undef PG8_SCHED
}
}
#define GAS __attribute__((address_space(1)))
#define LAS __attribute__((address_space(3)))
typedef unsigned short bf16;
typedef unsigned v4u __attribute__((ext_vector_type(4)));
typedef float f32x4 __attribute__((ext_vector_type(4)));
typedef short bf16x8 __attribute__((ext_vector_type(8)));
typedef GAS unsigned gu32;
typedef GAS unsigned long long gu64;
#define RLX_AGENT __ATOMIC_RELAXED, __HIP_MEMORY_SCOPE_AGENT
#define LDS_WAIT() asm volatile("s_waitcnt lgkmcnt(0)" ::: "memory")
#define VM_WAIT() asm volatile("s_waitcnt vmcnt(0)" ::: "memory")
__device__ __forceinline__ unsigned long long rt() { return __builtin_amdgcn_s_memrealtime(); }
__device__ __forceinline__ unsigned f2bf(float f) { unsigned u = __builtin_bit_cast(unsigned, f); return (u + 0x7fffu + ((u >> 16) & 1u)) >> 16; }
__device__ __forceinline__ unsigned pk2(float lo, float hi) { return f2bf(lo) | (f2bf(hi) << 16); }

#define XB_TMO      128
#define XB_XCNT(j)  (256  + 64 * (j))
#define XB_XSUB(j)  (1280 + 64 * (j))
#define XB_XGEN(j)  (2304 + 64 * (j))
#define XB_TOP      3328
#define XB_TOPGEN   3392
#define XCD_BAR_WORDS 3456
#define XB_SPIN_CAP (1u << 18)

__device__ __forceinline__ unsigned xb_ld(unsigned* p)              { return __hip_atomic_load(p, __ATOMIC_RELAXED, __HIP_MEMORY_SCOPE_AGENT); }
__device__ __forceinline__ unsigned xb_add(unsigned* p, unsigned v) { return __hip_atomic_fetch_add(p, v, __ATOMIC_RELAXED, __HIP_MEMORY_SCOPE_AGENT); }
__device__ __forceinline__ unsigned xb_xcc_id() { return (unsigned)__builtin_amdgcn_s_getreg((3 << 11) | 20) & 0xFu; }
#define XB_SPIN(cond, bar) do { unsigned _sp = 0; while (cond) { __builtin_amdgcn_s_sleep(1); \
    if ((++_sp & 255u) == 0u) { if (xb_ld(&(bar)[XB_TMO])) break; if (_sp > XB_SPIN_CAP) { atomicAdd(&(bar)[XB_TMO], 1u); break; } } } } while (0)

struct XcdBarrier {
    unsigned* bar; unsigned x;
    volatile LAS unsigned* st;
};

__device__ __forceinline__ XcdBarrier xcd_barrier_post(unsigned* bar, volatile LAS unsigned* st) {
    XcdBarrier b; b.bar = bar; b.x = xb_xcc_id(); b.st = st;
    if (threadIdx.x == 0) (void)xb_add(&bar[XB_XCNT(b.x)], 1u);
    return b;
}
__device__ __forceinline__ void xcd_barrier_complete(unsigned* bar, unsigned x, unsigned& nloc, unsigned& nx) {
    const unsigned G = gridDim.x * gridDim.y * gridDim.z;
    unsigned sum, cnt, mine, sp = 0u;
    for (;;) {
        sum = 0u; cnt = 0u; mine = 0u;
#pragma unroll
        for (unsigned j = 0; j < 16; ++j) { const unsigned c = xb_ld(&bar[XB_XCNT(j)]); sum += c; cnt += (c > 0u) ? 1u : 0u; mine = (j == x) ? c : mine; }
        if (sum == G) break;
        __builtin_amdgcn_s_sleep(1);
        if ((++sp & 255u) == 0u) { if (xb_ld(&bar[XB_TMO])) break; if (sp > XB_SPIN_CAP) { atomicAdd(&bar[XB_TMO], 1u); break; } }
    }
    nloc = mine > 0u ? mine : 1u; nx = cnt > 0u ? cnt : 1u;
}

__device__ __forceinline__ void xcd_barrier(const XcdBarrier& b) {
    asm volatile("s_waitcnt vmcnt(0)" ::: "memory");
    __syncthreads();
    int t0_ = threadIdx.x; asm volatile("" : "+v"(t0_));
    if (t0_ == 0) {
        size_t zb_ = 0; unsigned bx_ = b.x; asm volatile("" : "+s"(zb_), "+s"(bx_)); unsigned* bar = b.bar + zb_;
        __builtin_amdgcn_s_waitcnt(0);
        unsigned nloc = b.st[0], nx = b.st[1];
        if (nloc == 0u) { xcd_barrier_complete(bar, bx_, nloc, nx); b.st[0] = nloc; b.st[1] = nx; }
        const unsigned old = xb_add(&bar[XB_XSUB(bx_)], 1u);
        const unsigned gen = old / nloc;
        if (old + 1u == (gen + 1u) * nloc) {
            __builtin_amdgcn_fence(__ATOMIC_RELEASE, "agent");
            asm volatile("s_waitcnt vmcnt(0)" ::: "memory");
            const unsigned og = xb_add(&bar[XB_TOP], 1u);
            const unsigned tg = og / nx;
            if (og + 1u == (tg + 1u) * nx) xb_add(&bar[XB_TOPGEN], 1u);
            else XB_SPIN(xb_ld(&bar[XB_TOPGEN]) == tg, bar);
            __builtin_amdgcn_fence(__ATOMIC_ACQUIRE, "agent");
            xb_add(&bar[XB_XGEN(bx_)], 1u);
            asm volatile("s_waitcnt vmcnt(0)" ::: "memory");
        } else {
            XB_SPIN(xb_ld(&bar[XB_XGEN(bx_)]) == gen, bar);
            __builtin_amdgcn_fence(__ATOMIC_ACQUIRE, "agent");
            asm volatile("s_waitcnt vmcnt(0)" ::: "memory");
        }
    }
    __syncthreads();
}

constexpr int NWAVES = 8;
constexpr size_t MiB = 1u << 20;
constexpr size_t WS_CTL = 0, CTL_ZERO_BYTES = 1 * MiB;
constexpr size_t WS_ROPE = 1 * MiB;
constexpr size_t WS_WF = 5 * MiB;
constexpr size_t WS_LOGF = 6 * MiB, WS_CUM = 7 * MiB;
constexpr size_t WS_LSE = 8 * MiB;
constexpr size_t WS_P = 10 * MiB;
constexpr size_t WS_W = 74 * MiB, W_LAYER = 201 * MiB;
constexpr size_t WO_W1 = 0, WO_W2 = 44 * MiB, WO_W3 = 66 * MiB, WO_WA = 112 * MiB, WO_WB = 116 * MiB, WO_WO = 118 * MiB, WO_W6 = 126 * MiB, WO_W7 = 170 * MiB, WO_WP = 192 * MiB, WO_WG = 193 * MiB;
constexpr size_t WS_U = 878 * MiB;
constexpr size_t WS_BIG = 1006 * MiB;
constexpr size_t B_QA = 0, B_KA = 64 * MiB, B_VA = 128 * MiB;
constexpr size_t B_QB = 192 * MiB, B_KB = 288 * MiB, B_VB = 384 * MiB;
constexpr size_t B_GA = 480 * MiB, B_GB = 608 * MiB;
constexpr size_t B_H = 0;
constexpr size_t B_Y = 352 * MiB;
constexpr size_t B_T = 64 * MiB;
constexpr size_t WS_END = 1742 * MiB;
constexpr int CW_BAR = 4096;

constexpr int RING_OFF = 0, RING_BYTES = 131072;
constexpr int LDSCTL_OFF = RING_BYTES, MISC_OFF = LDSCTL_OFF + 320;
constexpr int LDS_BYTES = 147456;

__device__ const double INVF[64] = {
1.0, 0.8659643233600653, 0.7498942093324559, 0.6493816315762113,
0.5623413251903491, 0.4869675251658631, 0.4216965034285822, 0.3651741272548377,
0.31622776601683794, 0.27384196342643613, 0.23713737056616552, 0.2053525026457146,
0.1778279410038923, 0.1539926526059492, 0.1333521432163324, 0.11547819846894582,
0.1, 0.08659643233600653, 0.07498942093324558, 0.06493816315762113,
0.05623413251903491, 0.04869675251658631, 0.042169650342858224, 0.03651741272548377,
0.03162277660168379, 0.027384196342643614, 0.023713737056616554, 0.02053525026457146,
0.01778279410038923, 0.01539926526059492, 0.01333521432163324, 0.011547819846894581,
0.01, 0.008659643233600654, 0.007498942093324558, 0.006493816315762113,
0.005623413251903491, 0.004869675251658631, 0.004216965034285823, 0.003651741272548377,
0.0031622776601683794, 0.0027384196342643613, 0.0023713737056616554, 0.002053525026457146,
0.0017782794100389228, 0.001539926526059492, 0.001333521432163324, 0.0011547819846894581,
0.001, 0.0008659643233600654, 0.0007498942093324559, 0.0006493816315762113,
0.0005623413251903491, 0.0004869675251658631, 0.00042169650342858224, 0.0003651741272548377,
0.00031622776601683794, 0.0002738419634264361, 0.00023713737056616554, 0.0002053525026457146,
0.00017782794100389227, 0.0001539926526059492, 0.0001333521432163324, 0.00011547819846894582};

struct Frame {
    LAS unsigned char* lds;
    volatile LAS unsigned* MISC;
    int tid, lane, wave, vcu, G;
    unsigned char* ws;
};
__device__ __forceinline__ float wave_sum(float v) {
#pragma unroll
    for (int o = 1; o < 64; o <<= 1) v += __shfl_xor(v, o);
    return v;
}

__device__ __forceinline__ void tr_item(const float* W, int ldw, int c_src, int k0, bf16* dst, int K, LAS float* scr, int lane) {
#pragma unroll 8
    for (int i = 0; i < 32; ++i) { const int kk = 2 * i + (lane >> 5); scr[kk * 33 + (lane & 31)] = W[(size_t)(k0 + kk) * ldw + c_src + (lane & 31)]; }
    LDS_WAIT(); asm volatile("" ::: "memory");
    const int c = lane & 7;
#pragma unroll
    for (int j = 0; j < 4; ++j) { const int n = (lane >> 3) + 8 * j; const LAS float* s = scr + (8 * c) * 33 + n;
        v4u o; o.x = pk2(s[0 * 33], s[1 * 33]); o.y = pk2(s[2 * 33], s[3 * 33]); o.z = pk2(s[4 * 33], s[5 * 33]); o.w = pk2(s[6 * 33], s[7 * 33]);
        *(v4u*)(dst + (size_t)n * K + k0 + 8 * c) = o; }
    LDS_WAIT(); asm volatile("" ::: "memory");
}
constexpr int I_W1 = (DM / 64) * (2 * DFF / 32), I_W2 = (DFF / 64) * (DM / 32), I_W3 = (DM / 64) * 368, I_WA = (1024 / 64) * (DM / 32), I_WB = (512 / 64) * (DM / 32),
              I_WO = (DM / 64) * (DM / 32), I_WP = (PLE / 64) * (DM / 32), I_LAYER = 2 * I_W1 + 2 * I_W2 + I_W3 + I_WA + I_WB + 2 * I_WO + I_WP;
struct In { const float *x, *p, *norm_g, *ffn1_in, *ffn1_out, *mix_in, *fox_b, *br_a, *br_b, *mix_out, *ffn2_in, *ffn2_out, *ple_proj, *ple_gate; };

__device__ __forceinline__ void tr_swiglu(const float* W, bf16* WT, int r, LAS float* scr, int lane) {
    const int nb = r % 352, kb = r / 352, c0 = 32 * nb, part = c0 >= DFF ? 1 : 0, cp = c0 - part * DFF;
    const int drow = 256 * (cp / 128) + 128 * part + (cp % 128);
    tr_item(W, 2 * DFF, c0, 64 * kb, WT + (size_t)drow * DM, DM, scr, lane);
}
__device__ __forceinline__ void tr_plain(const float* W, int K, int N, bf16* WT, int r, LAS float* scr, int lane) {
    const int nblk = N / 32, nb = r % nblk, kb = r / nblk;
    tr_item(W, N, 32 * nb, 64 * kb, WT + (size_t)(32 * nb) * K, K, scr, lane);
}
__device__ __forceinline__ void tr_mix(const float* W, bf16* WT, int r, LAS float* scr, int lane) {
    const int nb = r % 368, kb = r / 368; int c_src, drow;
    if (nb < 96) { c_src = 32 * nb; drow = 32 * nb; }
    else if (nb < 240) { const int cc0 = 32 * (nb - 96); c_src = C_QB + cc0;
        if (cc0 < 3072) { const int t = cc0 / 1536, cq = cc0 % 1536, head = cq / 128, bj = (cq % 128) / 64, dd0 = cq % 64;
            drow = 3072 + 1536 * t + 256 * (head >> 1) + 128 * bj + 64 * (head & 1) + dd0; }
        else drow = 3072 + cc0; }
    else { const int cc0 = 32 * (nb - 240); c_src = C_GA + cc0; drow = 7680 + cc0; }
    tr_item(W, NCOLS, c_src, 64 * kb, WT + (size_t)drow * DM, DM, scr, lane);
}
__device__ __forceinline__ void sincos_d(double x, float& s, float& c) {
    const double q = __builtin_rint(x * 0.63661977236758134308);
    double r = __builtin_fma(-q, 1.5707963267948966192, x); r = __builtin_fma(-q, 6.123233995736766036e-17, r);
    const double r2 = r * r;
    double sp = -7.6471637318198164759e-13; sp = sp * r2 + 1.6059043836821614599e-10; sp = sp * r2 - 2.5052108385441718775e-08; sp = sp * r2 + 2.7557319223985890653e-06;
    sp = sp * r2 - 1.9841269841269841270e-04; sp = sp * r2 + 8.3333333333333333333e-03; sp = sp * r2 - 1.6666666666666666667e-01; const double sn = r + r * r2 * sp;
    double cp = 4.7794773323873852974e-14; cp = cp * r2 - 1.1470745597729724714e-11; cp = cp * r2 + 2.0876756987868098979e-09; cp = cp * r2 - 2.7557319223985890653e-07;
    cp = cp * r2 + 2.4801587301587301587e-05; cp = cp * r2 - 1.3888888888888888889e-03; cp = cp * r2 + 4.1666666666666666667e-02; cp = cp * r2 - 0.5; const double cs = 1.0 + r2 * cp;
    const int n = ((int)q) & 3;
    const double so = (n == 0) ? sn : (n == 1) ? cs : (n == 2) ? -sn : -cs;
    const double co = (n == 0) ? cs : (n == 1) ? -sn : (n == 2) ? -cs : sn;
    s = (float)so; c = (float)co;
}
__device__ __forceinline__ void p_prologue(Frame& F, const In& in) {
    LAS float* scr = (LAS float*)(F.lds + RING_OFF + F.wave * 16384);
    const int gw = F.vcu * NWAVES + F.wave, NGW = F.G * NWAVES;
    for (int it = gw; it < DEPTH * I_LAYER; it += NGW) {
        const int L = it / I_LAYER; int r = it - L * I_LAYER; unsigned char* wl = F.ws + WS_W + (size_t)L * W_LAYER;
        if (r < I_W1) { tr_swiglu(in.ffn1_in + (size_t)L * DM * 2 * DFF, (bf16*)(wl + WO_W1), r, scr, F.lane); continue; } r -= I_W1;
        if (r < I_W2) { tr_plain(in.ffn1_out + (size_t)L * DFF * DM, DFF, DM, (bf16*)(wl + WO_W2), r, scr, F.lane); continue; } r -= I_W2;
        if (r < I_W3) { tr_mix(in.mix_in + (size_t)L * DM * NCOLS, (bf16*)(wl + WO_W3), r, scr, F.lane); continue; } r -= I_W3;
        if (r < I_WA) { tr_plain(in.br_a + (size_t)L * 1024 * DM, 1024, DM, (bf16*)(wl + WO_WA), r, scr, F.lane); continue; } r -= I_WA;
        if (r < I_WB) { tr_plain(in.br_b + (size_t)L * 512 * DM, 512, DM, (bf16*)(wl + WO_WB), r, scr, F.lane); continue; } r -= I_WB;
        if (r < I_WO) { tr_plain(in.mix_out + (size_t)L * DM * DM, DM, DM, (bf16*)(wl + WO_WO), r, scr, F.lane); continue; } r -= I_WO;
        if (r < I_W1) { tr_swiglu(in.ffn2_in + (size_t)L * DM * 2 * DFF, (bf16*)(wl + WO_W6), r, scr, F.lane); continue; } r -= I_W1;
        if (r < I_W2) { tr_plain(in.ffn2_out + (size_t)L * DFF * DM, DFF, DM, (bf16*)(wl + WO_W7), r, scr, F.lane); continue; } r -= I_W2;
        if (r < I_WP) { tr_plain(in.ple_proj + (size_t)L * PLE * DM, PLE, DM, (bf16*)(wl + WO_WP), r, scr, F.lane); continue; } r -= I_WP;
        tr_plain(in.ple_gate + (size_t)L * DM * DM, DM, DM, (bf16*)(wl + WO_WG), r, scr, F.lane);
    }
    const size_t gt = (size_t)blockIdx.x * 512 + F.tid, NT = (size_t)F.G * 512;
    { const f32x4* ps = (const f32x4*)in.p; v4u* pd = (v4u*)(F.ws + WS_P);
      for (size_t i = gt; i < (size_t)DEPTH * M * PLE / 8; i += NT) { const f32x4 a = ps[2 * i], b = ps[2 * i + 1];
          v4u o; o.x = pk2(a[0], a[1]); o.y = pk2(a[2], a[3]); o.z = pk2(b[0], b[1]); o.w = pk2(b[2], b[3]); pd[i] = o; } }
    { float* ct = (float*)(F.ws + WS_ROPE); float* st = ct + SEQ * 64;
      for (size_t i = gt; i < (size_t)SEQ * 64; i += NT) { const int t = (int)(i >> 6), dd = (int)(i & 63); float s, c; sincos_d((double)t * INVF[dd], s, c); ct[i] = c; st[i] = s; } }
    { float* wf = (float*)(F.ws + WS_WF);
      for (size_t i = gt; i < (size_t)DEPTH * 8 * DM; i += NT) { const int L = (int)(i / (8 * DM)), h = (int)((i / DM) & 7), k = (int)(i % DM);
          wf[i] = in.mix_in[((size_t)L * DM + k) * NCOLS + C_F + h]; } }
}

template <bool WITH_F, bool HAS_Y, bool HAS_U>
__device__ __forceinline__ void norm_pass(Frame& F, const float* xin, const float* y, float coef, const float* gpost, const float* gpre, float* xout, bf16* U, const float* bfox, float* logf) {
    const int gw = F.vcu * NWAVES + F.wave, NGW = F.G * NWAVES;
    const LAS f32x4* wfl = (const LAS f32x4*)(F.lds + RING_OFF);
    for (int row = gw; row < M; row += NGW) {
        const f32x4* xr = (const f32x4*)(xin + (size_t)row * DM) + F.lane;
        f32x4 xv[8];
#pragma unroll
        for (int j = 0; j < 8; ++j) xv[j] = xr[64 * j];
        if (HAS_Y) {
            const f32x4* yr = (const f32x4*)(y + (size_t)row * DM) + F.lane; f32x4 yv[8]; float ss = 0.f;
#pragma unroll
            for (int j = 0; j < 8; ++j) { yv[j] = yr[64 * j]; ss += (yv[j][0] * yv[j][0] + yv[j][1] * yv[j][1]) + (yv[j][2] * yv[j][2] + yv[j][3] * yv[j][3]); }
            const float ry = coef / sqrtf(wave_sum(ss) * (1.f / DM) + RMS_EPS);
#pragma unroll
            for (int j = 0; j < 8; ++j) { const f32x4 g = ((const f32x4*)gpost)[F.lane + 64 * j]; xv[j] += yv[j] * ry * g; }
        }
        { f32x4* xo = (f32x4*)(xout + (size_t)row * DM) + F.lane;
#pragma unroll
            for (int j = 0; j < 8; ++j) xo[64 * j] = xv[j]; }
        if (HAS_U) {
            float ss = 0.f;
#pragma unroll
            for (int j = 0; j < 8; ++j) ss += (xv[j][0] * xv[j][0] + xv[j][1] * xv[j][1]) + (xv[j][2] * xv[j][2] + xv[j][3] * xv[j][3]);
            const float rx = 1.f / sqrtf(wave_sum(ss) * (1.f / DM) + RMS_EPS);
            unsigned long long* uo = (unsigned long long*)(U + (size_t)row * DM) + F.lane;
#pragma unroll
            for (int j = 0; j < 8; ++j) { const f32x4 g = ((const f32x4*)gpre)[F.lane + 64 * j]; xv[j] = xv[j] * rx * g;
                uo[64 * j] = (unsigned long long)pk2(xv[j][0], xv[j][1]) | ((unsigned long long)pk2(xv[j][2], xv[j][3]) << 32); }
            if (WITH_F) {
                float mine = 0.f;
#pragma unroll 1
                for (int h = 0; h < 8; ++h) { float a = 0.f;
#pragma unroll
                    for (int j = 0; j < 8; ++j) { const f32x4 w = wfl[h * 512 + F.lane + 64 * j]; a += (xv[j][0] * w[0] + xv[j][1] * w[1]) + (xv[j][2] * w[2] + xv[j][3] * w[3]); }
                    a = wave_sum(a); mine = (F.lane == h) ? a : mine; }
                if (F.lane < 8) { const float v = mine + bfox[F.lane];
                    const float ls = (v >= 0.f) ? -log1pf(expf(-v)) : (v - log1pf(expf(v)));
                    const int b = row / SEQ, t = row - b * SEQ; logf[(size_t)(b * 8 + F.lane) * SEQ + t] = ls; }
            }
        }
    }
}
__device__ __forceinline__ void scan_phase(Frame& F, int bid) {
    if (bid >= 32) return;
    const float* lf = (const float*)(F.ws + WS_LOGF) + (size_t)bid * SEQ; float* cs = (float*)(F.ws + WS_CUM) + (size_t)bid * SEQ;
    LAS double* wt = (LAS double*)(F.lds + RING_OFF);
    f32x4 v[4]; double run = 0.0; double pre[16];
#pragma unroll
    for (int j = 0; j < 4; ++j) v[j] = ((const f32x4*)lf)[F.tid * 4 + j];
#pragma unroll
    for (int j = 0; j < 4; ++j)
#pragma unroll
        for (int e = 0; e < 4; ++e) { run += (double)v[j][e]; pre[4 * j + e] = run; }
    double incl = run;
#pragma unroll
    for (int o = 1; o < 64; o <<= 1) { const double t = __shfl_up(incl, o); if (F.lane >= o) incl += t; }
    if (F.lane == 63) wt[F.wave] = incl;
    LDS_WAIT(); __syncthreads();
    double base = incl - run;
    for (int w = 0; w < F.wave; ++w) base += wt[w];
#pragma unroll
    for (int j = 0; j < 4; ++j) { f32x4 o;
#pragma unroll
        for (int e = 0; e < 4; ++e) o[e] = (float)(base + pre[4 * j + e]);
        ((f32x4*)cs)[F.tid * 4 + j] = o; }
    __syncthreads();
}
__device__ __forceinline__ void combine_phase(Frame& F) {
    const int gw = F.vcu * NWAVES + F.wave, NGW = F.G * NWAVES;
    const float* lse = (const float*)(F.ws + WS_LSE); const bf16* og = (const bf16*)(F.ws + WS_BIG + B_QB); bf16* ob = (bf16*)(F.ws + WS_U);
    const int j = F.lane >> 4, d8 = (F.lane & 15) * 8;
    for (int tok = gw; tok < M; tok += NGW) {
        const float l0 = lse[(size_t)tok * 4 + j], l1 = lse[((size_t)M + tok) * 4 + j], l2 = lse[((size_t)2 * M + tok) * 4 + j];
        const float mx = fmaxf(l0, fmaxf(l1, l2)); const float e0 = expf(l0 - mx), e1 = expf(l1 - mx), e2 = expf(l2 - mx), inv = 1.f / (e0 + e1 + e2);
        const bf16* r = og + (size_t)tok * 1536 + j * 128 + d8;
        f32x4 a0, a1, b0, b1, c0, c1; pg8::unpack8(*(const v4u*)r, a0, a1); pg8::unpack8(*(const v4u*)(r + 512), b0, b1); pg8::unpack8(*(const v4u*)(r + 1024), c0, c1);
        const float w0 = e0 * inv, w1 = e1 * inv, w2 = e2 * inv;
        *(v4u*)(ob + (size_t)tok * 512 + j * 128 + d8) = pg8::pack8(a0 * w0 + b0 * w1 + c0 * w2, a1 * w0 + b1 * w1 + c1 * w2);
    }
}

__global__ __launch_bounds__(256) void naive_attn(unsigned char* ws, int mode) {
    __shared__ __attribute__((aligned(16))) bf16 Kt[64 * 128];
    __shared__ __attribute__((aligned(16))) bf16 Vt[64 * 128];
    __shared__ float biasl[64];
    const int tid = threadIdx.x, qi = tid >> 2, part = tid & 3;
    const bf16 *Q, *K, *V; float* lse = nullptr; const float* cum = nullptr; int pitch, W, P0, lstride = 0;
    if (mode == 0) { const int it = blockIdx.x, qb = 127 - it / 32, s = it % 32, b = s >> 3, h = s & 7; const size_t off = (size_t)b * SEQ * 1024 + h * 128;
        Q = (const bf16*)(ws + WS_BIG + B_QA) + off; K = (const bf16*)(ws + WS_BIG + B_KA) + off; V = (const bf16*)(ws + WS_BIG + B_VA) + off; pitch = 1024; W = 1 << 30; P0 = qb * 64;
        cum = (const float*)(ws + WS_CUM) + (size_t)s * SEQ; }
    else { const int it = blockIdx.x, g = it / 2048, r = it % 2048, d = (g == 0) ? 1 : (g == 1) ? 4 : 16, L = SEQ / d, nqb = L / 64, seq = r / nqb, qb = r % nqb;
        const int b = seq / (4 * d), j = (seq / d) & 3, res = seq % d, head = 4 * g + j; const size_t off = ((size_t)b * SEQ + res) * 1536 + head * 128;
        Q = (const bf16*)(ws + WS_BIG + B_QB) + off; K = (const bf16*)(ws + WS_BIG + B_KB) + off; V = (const bf16*)(ws + WS_BIG + B_VB) + off; pitch = d * 1536; W = 129; P0 = qb * 64;
        lse = (float*)(ws + WS_LSE) + ((size_t)g * M + (size_t)b * SEQ + res) * 4 + j; lstride = d * 4; }
    const int i = P0 + qi;
    float q[32], o[32];
    { const v4u* qp = (const v4u*)(Q + (size_t)i * pitch + 32 * part);
#pragma unroll
      for (int c = 0; c < 4; ++c) { f32x4 a, b; pg8::unpack8(qp[c], a, b);
#pragma unroll
          for (int e = 0; e < 4; ++e) { q[8 * c + e] = a[e]; q[8 * c + 4 + e] = b[e]; } } }
#pragma unroll
    for (int e = 0; e < 32; ++e) o[e] = 0.f;
    const float ci = cum ? cum[i] : 0.f;
    float m = -1e30f, l = 0.f;
    int jstart = P0 - (W - 1); if (jstart < 0 || W > SEQ) jstart = 0; jstart &= ~63;
    for (int j0 = jstart; j0 < P0 + 64; j0 += 64) {
        __syncthreads();
#pragma unroll
        for (int c = 0; c < 4; ++c) { const int idx = tid + 256 * c, row = idx >> 4, ch = idx & 15;
            *(v4u*)(Kt + row * 128 + ch * 8) = *(const v4u*)(K + (size_t)(j0 + row) * pitch + ch * 8);
            *(v4u*)(Vt + row * 128 + ch * 8) = *(const v4u*)(V + (size_t)(j0 + row) * pitch + ch * 8); }
        if (cum && tid < 64) biasl[tid] = cum[j0 + tid];
        __syncthreads();
        for (int kk0 = 0; kk0 < 64; kk0 += 8) {
            float s[8]; float cmax = -__builtin_inff();
#pragma unroll
            for (int e = 0; e < 8; ++e) { const int kk = kk0 + e; const v4u* kp = (const v4u*)(Kt + kk * 128 + 32 * part); float dot = 0.f;
#pragma unroll
                for (int c = 0; c < 4; ++c) { f32x4 a, b; pg8::unpack8(kp[c], a, b);
#pragma unroll
                    for (int x = 0; x < 4; ++x) dot += q[8 * c + x] * a[x] + q[8 * c + 4 + x] * b[x]; }
                dot += __shfl_xor(dot, 1); dot += __shfl_xor(dot, 2);
                const int jj = j0 + kk; const bool valid = (jj <= i) && (i - jj < W);
                float sc = dot * ATT_SCALE; if (cum) sc += ci - biasl[kk];
                s[e] = valid ? sc : -__builtin_inff(); cmax = fmaxf(cmax, s[e]); }
            const float mn = fmaxf(m, cmax), alpha = expf(m - mn); m = mn; l *= alpha;
#pragma unroll
            for (int e = 0; e < 32; ++e) o[e] *= alpha;
#pragma unroll
            for (int e = 0; e < 8; ++e) { const float p = expf(s[e] - mn); l += p; const v4u* vp = (const v4u*)(Vt + (kk0 + e) * 128 + 32 * part);
#pragma unroll
                for (int c = 0; c < 4; ++c) { f32x4 a, b; pg8::unpack8(vp[c], a, b);
#pragma unroll
                    for (int x = 0; x < 4; ++x) { o[8 * c + x] += p * a[x]; o[8 * c + 4 + x] += p * b[x]; } } }
        }
    }
    const float inv = 1.f / l;
    { v4u* op = (v4u*)(const_cast<bf16*>(Q) + (size_t)i * pitch + 32 * part);
#pragma unroll
      for (int c = 0; c < 4; ++c) op[c] = pg8::pack8((f32x4){o[8 * c] * inv, o[8 * c + 1] * inv, o[8 * c + 2] * inv, o[8 * c + 3] * inv}, (f32x4){o[8 * c + 4] * inv, o[8 * c + 5] * inv, o[8 * c + 6] * inv, o[8 * c + 7] * inv}); }
    if (lse && part == 0) lse[(size_t)i * lstride] = m + logf(l);
}

constexpr int NPH_LAYER = 14, PH_TOTAL = 2 + DEPTH * NPH_LAYER;
struct Args { const float* in[14]; float* out; unsigned char* ws; int lo, hi; };
__global__ void __launch_bounds__(NWAVES * 64, 2) fwd(Args args) {
    extern __shared__ __attribute__((aligned(16))) unsigned char lds[];
    Frame F;
    F.lds = (LAS unsigned char*)lds; F.MISC = (volatile LAS unsigned*)(F.lds + MISC_OFF);
    F.tid = threadIdx.x; F.lane = F.tid & 63; F.wave = __builtin_amdgcn_readfirstlane(F.tid >> 6);
    F.G = gridDim.x; { const int bx = blockIdx.x; F.vcu = (F.G % 8 == 0) ? (bx % 8) * (F.G / 8) + bx / 8 : bx; }
    F.ws = args.ws;
    In in; in.x = args.in[0]; in.p = args.in[1]; in.norm_g = args.in[2]; in.ffn1_in = args.in[3]; in.ffn1_out = args.in[4]; in.mix_in = args.in[5]; in.fox_b = args.in[6]; in.br_a = args.in[7];
    in.br_b = args.in[8]; in.mix_out = args.in[9]; in.ffn2_in = args.in[10]; in.ffn2_out = args.in[11]; in.ple_proj = args.in[12]; in.ple_gate = args.in[13];
    for (int u = F.tid; u < (LDS_BYTES - LDSCTL_OFF) / 4; u += NWAVES * 64) ((LAS unsigned*)(F.lds + LDSCTL_OFF))[u] = 0u;
    __syncthreads();
    XcdBarrier bar = xcd_barrier_post((unsigned*)(F.ws + WS_CTL) + CW_BAR, F.MISC + 8);
#define IN(k) (lo <= (k) && (k) < hi)
#ifndef PH_MASK
#define PH_MASK 0xffff
#endif
#define PHM(k) (((PH_MASK) >> (k)) & 1)
#define SEAM(k) do { if (IN(k) && IN((k) + 1)) xcd_barrier(bar); } while (0)
    LAS unsigned char* const ring = F.lds + RING_OFF;

    { const int lo = args.lo, hi = args.hi; if (PHM(14) && IN(0)) { p_prologue(F, in); SEAM(0); } }

    for (int L = 0; L < DEPTH; ++L) {
        size_t z_ = 0; int lo = args.lo, hi = args.hi;
        asm volatile("" : "+s"(z_), "+s"(lo), "+s"(hi));
        unsigned char* ws_ = args.ws + z_; float* out_ = args.out + z_; const float* ng_ = args.in[2] + z_; const float* fb_ = args.in[6] + z_;
        F.ws = ws_; in.norm_g = ng_; in.fox_b = fb_;
        unsigned char* const big = F.ws + WS_BIG; bf16* const U = (bf16*)(F.ws + WS_U); float* const Y = (float*)(big + B_Y); float* const xres = out_;
        { int t_ = threadIdx.x; asm volatile("" : "+v"(t_)); F.tid = t_; F.lane = t_ & 63; F.wave = __builtin_amdgcn_readfirstlane(t_ >> 6); }
        int bid_ = blockIdx.x, G_ = gridDim.x; asm volatile("" : "+s"(bid_), "+s"(G_));
        F.G = G_; F.vcu = (G_ % 8 == 0) ? (bid_ % 8) * (G_ / 8) + bid_ / 8 : bid_;
        const int pb = 1 + NPH_LAYER * L; unsigned char* const wl = F.ws + WS_W + (size_t)L * W_LAYER; const float* const g = in.norm_g + (size_t)L * 8 * DM;
        if (PHM(0) && IN(pb + 0)) {
            if (L == 0) norm_pass<false, false, true>(F, in.x, nullptr, 0.f, nullptr, g + 0 * DM, xres, U, nullptr, nullptr);
            else norm_pass<false, true, true>(F, xres, Y, 1.f, g - 8 * DM + 7 * DM, g + 0 * DM, xres, U, nullptr, nullptr);
            SEAM(pb + 0); }
        if (PHM(1) && IN(pb + 1)) { pg8::Gemm gm{U, (const bf16*)(wl + WO_W1), M, 2 * DFF, DM}; pg8::StaticOrder S; S.init(M, 2 * DFF, F.G, bid_);
            pg8::EpiSwiGLU E{(bf16*)(big + B_H), DFF}; pg8::gemm_phase<pg8::EpiSwiGLU, pg8::StaticOrder, true, true>(ring, gm, S, E); SEAM(pb + 1); }
        if (PHM(2) && IN(pb + 2)) { pg8::Gemm gm{(const bf16*)(big + B_H), (const bf16*)(wl + WO_W2), M, DM, DFF}; pg8::StaticOrder S; S.init(M, DM, F.G, bid_);
            pg8::EpiF32<0> E{Y, DM}; pg8::gemm_phase<pg8::EpiF32<0>, pg8::StaticOrder, true, true>(ring, gm, S, E); SEAM(pb + 2); }
        if (PHM(3) && IN(pb + 3)) {
            { const float* wf = (const float*)(F.ws + WS_WF) + (size_t)L * 8 * DM; LAS float* wl_ = (LAS float*)ring;
              for (int i = F.tid; i < 8 * DM; i += NWAVES * 64) wl_[i] = wf[i];
              LDS_WAIT(); __syncthreads(); }
            norm_pass<true, true, true>(F, xres, Y, 0.5f, g + 1 * DM, g + 2 * DM, xres, U, in.fox_b + L * 8, (float*)(F.ws + WS_LOGF));
            SEAM(pb + 3); }
        if (PHM(4) && IN(pb + 4)) {
#ifndef P4MASK
#define P4MASK 31
#endif
            if (P4MASK & 16) scan_phase(F, bid_);
            const bf16* W3 = (const bf16*)(wl + WO_W3);
            if (P4MASK & 1) { pg8::Gemm gm{U, W3, M, 3072, DM}; pg8::StaticOrder S; S.init(M, 3072, F.G, bid_);
              pg8::EpiSplitBf16<0> E{(bf16*)(big + B_QA), 1024, 1024, (size_t)M * 1024}; pg8::gemm_phase<pg8::EpiSplitBf16<0>, pg8::StaticOrder, true, true>(ring, gm, S, E); }
            if (P4MASK & 2) { pg8::Gemm gm{U, W3 + (size_t)3072 * DM, M, 3072, DM}; pg8::StaticOrder S; S.init(M, 3072, F.G, bid_);
              pg8::EpiRope E{(bf16*)(big + B_QB), (bf16*)(big + B_KB), (const float*)(F.ws + WS_ROPE), (const float*)(F.ws + WS_ROPE) + SEQ * 64}; pg8::gemm_phase<pg8::EpiRope, pg8::StaticOrder, true, true>(ring, gm, S, E); }
            if (P4MASK & 4) { pg8::Gemm gm{U, W3 + (size_t)6144 * DM, M, 1536, DM}; pg8::StaticOrder S; S.init(M, 1536, F.G, bid_);
              pg8::EpiSplitBf16<0> E{(bf16*)(big + B_VB), 1536, 0, 0}; pg8::gemm_phase<pg8::EpiSplitBf16<0>, pg8::StaticOrder, true, true>(ring, gm, S, E); }
            if (P4MASK & 8) { pg8::Gemm gm{U, W3 + (size_t)7680 * DM, M, 4096, DM}; pg8::StaticOrder S; S.init(M, 4096, F.G, bid_);
              pg8::EpiSplitBf16<1> E{(bf16*)(big + B_GA), 2048, 2048, (size_t)M * 2048}; pg8::gemm_phase<pg8::EpiSplitBf16<1>, pg8::StaticOrder, true, true>(ring, gm, S, E); }
            SEAM(pb + 4); }
        if (PHM(5) && IN(pb + 5)) { SEAM(pb + 5); }
        if (PHM(6) && IN(pb + 6)) { combine_phase(F); SEAM(pb + 6); }
        if (PHM(7) && IN(pb + 7)) {
            { pg8::Gemm gm{(const bf16*)(big + B_QA), (const bf16*)(wl + WO_WA), M, DM, 1024}; pg8::StaticOrder S; S.init(M, DM, F.G, bid_);
              pg8::EpiGate<0> E{(const bf16*)(big + B_GA), (bf16*)(big + B_T)}; pg8::gemm_phase<pg8::EpiGate<0>, pg8::StaticOrder, true, true>(ring, gm, S, E); }
            { pg8::Gemm gm{(const bf16*)(F.ws + WS_U), (const bf16*)(wl + WO_WB), M, DM, 512}; pg8::StaticOrder S; S.init(M, DM, F.G, bid_);
              pg8::EpiGate<1> E{(const bf16*)(big + B_GB), (bf16*)(big + B_T)}; pg8::gemm_phase<pg8::EpiGate<1>, pg8::StaticOrder, true, true>(ring, gm, S, E); }
            SEAM(pb + 7); }
        if (PHM(8) && IN(pb + 8)) { pg8::Gemm gm{(const bf16*)(big + B_T), (const bf16*)(wl + WO_WO), M, DM, DM}; pg8::StaticOrder S; S.init(M, DM, F.G, bid_);
            pg8::EpiF32<0> E{Y, DM}; pg8::gemm_phase<pg8::EpiF32<0>, pg8::StaticOrder, true, true>(ring, gm, S, E); SEAM(pb + 8); }
        if (PHM(9) && IN(pb + 9)) { norm_pass<false, true, true>(F, xres, Y, 1.f, g + 3 * DM, g + 4 * DM, xres, U, nullptr, nullptr); SEAM(pb + 9); }
        if (PHM(10) && IN(pb + 10)) { pg8::Gemm gm{U, (const bf16*)(wl + WO_W6), M, 2 * DFF, DM}; pg8::StaticOrder S; S.init(M, 2 * DFF, F.G, bid_);
            pg8::EpiSwiGLU E{(bf16*)(big + B_H), DFF}; pg8::gemm_phase<pg8::EpiSwiGLU, pg8::StaticOrder, true, true>(ring, gm, S, E); SEAM(pb + 10); }
        if (PHM(11) && IN(pb + 11)) { pg8::Gemm gm{(const bf16*)(big + B_H), (const bf16*)(wl + WO_W7), M, DM, DFF}; pg8::StaticOrder S; S.init(M, DM, F.G, bid_);
            pg8::EpiF32<0> E{Y, DM}; pg8::gemm_phase<pg8::EpiF32<0>, pg8::StaticOrder, true, true>(ring, gm, S, E); SEAM(pb + 11); }
        if (PHM(12) && IN(pb + 12)) { norm_pass<false, true, true>(F, xres, Y, 0.5f, g + 5 * DM, g + 6 * DM, xres, U, nullptr, nullptr); SEAM(pb + 12); }
        if (PHM(13) && IN(pb + 13)) {
            { pg8::Gemm gm{(const bf16*)(F.ws + WS_P) + (size_t)L * M * PLE, (const bf16*)(wl + WO_WP), M, DM, PLE}; pg8::StaticOrder S; S.init(M, DM, F.G, bid_);
              pg8::EpiF32<0> E{Y, DM}; pg8::gemm_phase<pg8::EpiF32<0>, pg8::StaticOrder, true, true>(ring, gm, S, E); }
            { pg8::Gemm gm{U, (const bf16*)(wl + WO_WG), M, DM, DM}; pg8::StaticOrder S; S.init(M, DM, F.G, bid_);
              pg8::EpiF32<1> E{Y, DM}; pg8::gemm_phase<pg8::EpiF32<1>, pg8::StaticOrder, true, true>(ring, gm, S, E); }
            SEAM(pb + 13); }
    }
    { size_t z_ = 0; int lo = args.lo, hi = args.hi; asm volatile("" : "+s"(z_), "+s"(lo), "+s"(hi)); { int t_ = threadIdx.x; asm volatile("" : "+v"(t_)); F.tid = t_; F.lane = t_ & 63; F.wave = __builtin_amdgcn_readfirstlane(t_ >> 6); }
      { int bid_ = blockIdx.x, G_ = gridDim.x; asm volatile("" : "+s"(bid_), "+s"(G_)); F.G = G_; F.vcu = (G_ % 8 == 0) ? (bid_ % 8) * (G_ / 8) + bid_ / 8 : bid_; }
      float* const xres = args.out + z_; float* const Y = (float*)(args.ws + z_ + WS_BIG + B_Y); F.ws = args.ws + z_; in.norm_g = args.in[2] + z_;
    if (PHM(15) && IN(PH_TOTAL - 1)) norm_pass<false, true, false>(F, xres, Y, 1.f, in.norm_g + (size_t)(DEPTH - 1) * 8 * DM + 7 * DM, nullptr, xres, nullptr, nullptr, nullptr); }
#undef IN
#undef SEAM
}

__global__ void dump_fold(const unsigned short* src, size_t n, float* out, size_t nout) {
    for (size_t i = (size_t)blockIdx.x * blockDim.x + threadIdx.x; i < nout; i += (size_t)gridDim.x * blockDim.x) {
        float s = 0.f; for (size_t k = i; k < n; k += nout) { const unsigned short v = src[k]; const unsigned short e = (v >> 7) & 0xff; const float f = (e == 0xff) ? 12345.f : __uint_as_float(((unsigned)v) << 16); s += f; }
        out[i] = s; }
}
extern "C" void kernel_launch(void* const* d_in, const int* in_sizes, int n_in, void* d_out, int out_size, void* d_ws, size_t ws_size, hipStream_t stream) {
    static int grid = 0;
    if (grid == 0) {
        if (n_in != 14 || in_sizes[0] != M * DM || out_size != M * DM || ws_size < WS_END) { fprintf(stderr, "kernel_launch: unexpected shapes / workspace (n_in %d, ws %zu < %zu); nothing launched\n", n_in, ws_size, (size_t)WS_END); grid = -1; return; }
        int dev = 0, cus = 0;
        if (hipGetDevice(&dev) != hipSuccess || hipDeviceGetAttribute(&cus, hipDeviceAttributeMultiprocessorCount, dev) != hipSuccess) { grid = -1; return; }
        if (hipFuncSetAttribute((const void*)fwd, hipFuncAttributeMaxDynamicSharedMemorySize, LDS_BYTES) != hipSuccess) { fprintf(stderr, "kernel_launch: hipFuncSetAttribute failed\n"); grid = -1; return; }
        int per_cu = 0; (void)hipOccupancyMaxActiveBlocksPerMultiprocessor(&per_cu, (const void*)fwd, NWAVES * 64, LDS_BYTES); (void)hipGetLastError();
        grid = cus;
    }
    if (grid < 0) return;
    (void)hipMemsetAsync((char*)d_ws + WS_CTL, 0, CTL_ZERO_BYTES, stream);
    Args a{};
    for (int i = 0; i < 14; ++i) a.in[i] = (const float*)d_in[i];
    a.out = (float*)d_out; a.ws = (unsigned char*)d_ws;
#if MK_BRINGUP
#ifndef STOP_AT
#define STOP_AT PH_TOTAL
#endif
    for (int ph = 0; ph < STOP_AT; ++ph) {
        const int p = (ph >= 1 && ph < PH_TOTAL - 1) ? (ph - 1) % NPH_LAYER : -1;
        if (p == 5) { hipLaunchKernelGGL(naive_attn, dim3(4096), dim3(256), 0, stream, (unsigned char*)d_ws, 0); hipLaunchKernelGGL(naive_attn, dim3(6144), dim3(256), 0, stream, (unsigned char*)d_ws, 1); continue; }
        a.lo = ph; a.hi = ph + 1;
        hipLaunchKernelGGL(fwd, dim3(grid), dim3(NWAVES * 64), LDS_BYTES, stream, a);
    }
#ifdef DUMP_OFF
    hipLaunchKernelGGL(dump_fold, dim3(2048), dim3(256), 0, stream, (const unsigned short*)((unsigned char*)d_ws + (size_t)(DUMP_OFF)), (size_t)(DUMP_N), (float*)d_out, (size_t)M * DM);
#endif
#else
    a.lo = 0; a.hi = PH_TOTAL;
    hipLaunchKernelGGL(fwd, dim3(grid), dim3(NWAVES * 64), LDS_BYTES, stream, a);
#endif
}
```

```cpp
#include <hip/hip_runtime.h>
#include <cstdio>
#include <cstdint>

constexpr int DM = 2048, NBATCH = 4, SEQ = 8192, DEPTH = 4, HD = 128, FOXH = 8, DILH = 12, DFF = 5632, PLE = 256;
constexpr int M = NBATCH * SEQ;
constexpr int NCOLS = 11784;
constexpr int C_F = 3072, C_QB = 3080, C_GA = 7688;
constexpr float RMS_EPS = 1e-6f;
constexpr float ATT_SCALE = 0.08838834764831845f;

#ifndef MK_BRINGUP
#define MK_BRINGUP 0
#endif
namespace pg8 {
#define PG8_LAS __attribute__((address_space(3)))
typedef unsigned short bf16_t;
typedef short bf16x8 __attribute__((ext_vector_type(8)));
typedef float f32x4 __attribute__((ext_vector_type(4)));
typedef unsigned u32x4 __attribute__((ext_vector_type(4)));
constexpr int BM = 256, BK = 64, HALF = 128, HTB = HALF * BK * 2  , STAGE_BYTES = 8 * HTB, NXCD = 8, WGM = 8;

__host__ __device__ __forceinline__ int lds_byte(int r, int c) { const int st = (r >> 4) * 2 + (c >> 5), rr = r & 15, cc = c & 31, ob = rr * 64 + cc * 2; return st * 1024 + (ob ^ (((ob >> 9) & 1) << 5)); }
__host__ __device__ __forceinline__ void stage_rc(int b, int& R, int& C) { const int st = b / 1024, sb = b % 1024, swz = sb ^ (((sb >> 9) & 1) << 5); R = (st >> 1) * 16 + swz / 64; C = (st & 1) * 32 + (swz % 64) / 2; }
__host__ __device__ __forceinline__ int perm32(int rho) { const int n = rho >> 4, i = rho & 15; return 8 * (i >> 2) + 4 * n + (i & 3); }

struct Unit { int pm, pn; };
struct Gemm { const bf16_t* A; const bf16_t* Bt; int M, N, K; int wave = 0; int a_tiled = 0; };

struct StaticOrder {
    int nM, nN, nwg, G, c, wgm;
    __host__ __device__ void init(int M, int N, int G_, int c_, int wgm_ = WGM) { nM = M / BM; nN = N / BM; nwg = nM * nN; G = G_; c = c_; wgm = wgm_; }
    __host__ __device__ bool next(int i, Unit& u) const {
        const long L = (long)i * G + c; if (L >= nwg) return false;
        int wgid = (int)L; { const int q = nwg / NXCD, r = nwg % NXCD, xcd = wgid % NXCD, off = wgid / NXCD; wgid = (xcd < r ? xcd * (q + 1) : r * (q + 1) + (xcd - r) * q) + off; }
        const int nig = wgm * nN, gid = wgid / nig, fm = gid * wgm, gsz = (nM - fm) < wgm ? (nM - fm) : wgm;
        u.pm = fm + ((wgid % nig) % gsz); u.pn = (wgid % nig) / gsz; return true;
    }
    __device__ __forceinline__ void a_ready(const Unit&) const {}
    __device__ __forceinline__ void done(const Unit&) const {}
};

typedef __bf16 bf16x2_hw __attribute__((ext_vector_type(2)));
typedef float f32x2_hw __attribute__((ext_vector_type(2)));
__device__ __forceinline__ unsigned cvt_pk_bf16(float lo, float hi) { const f32x2_hw v = {lo, hi}; const bf16x2_hw r = __builtin_convertvector(v, bf16x2_hw); return __builtin_bit_cast(unsigned, r); }
__device__ __forceinline__ int lane_id_now() { int l; asm volatile("v_mbcnt_lo_u32_b32 %0, -1, 0\n\tv_mbcnt_hi_u32_b32 %0, -1, %0" : "=v"(l)); return l; }
typedef float f32x2 __attribute__((ext_vector_type(2)));
__device__ __forceinline__ float sigmoidf_(float v) { return __builtin_amdgcn_rcpf(1.0f + __builtin_amdgcn_exp2f(-1.4426950408889634f * v)); }
__device__ __forceinline__ f32x4 sigmoid4(f32x4 v) { return (f32x4){sigmoidf_(v[0]), sigmoidf_(v[1]), sigmoidf_(v[2]), sigmoidf_(v[3])}; }
__device__ __forceinline__ u32x4 pack8(f32x4 v0, f32x4 v1) { u32x4 w; w.x = cvt_pk_bf16(v0[0], v0[1]); w.y = cvt_pk_bf16(v0[2], v0[3]); w.z = cvt_pk_bf16(v1[0], v1[1]); w.w = cvt_pk_bf16(v1[2], v1[3]); return w; }
__device__ __forceinline__ void unpack8(u32x4 w, f32x4& v0, f32x4& v1) {
    v0 = (f32x4){__uint_as_float(w.x << 16), __uint_as_float(w.x & 0xffff0000u), __uint_as_float(w.y << 16), __uint_as_float(w.y & 0xffff0000u)};
    v1 = (f32x4){__uint_as_float(w.z << 16), __uint_as_float(w.z & 0xffff0000u), __uint_as_float(w.w << 16), __uint_as_float(w.w & 0xffff0000u)}; }

template <int CTRL> __device__ __forceinline__ float dpp_mov(float v) { return __int_as_float(__builtin_amdgcn_update_dpp(0, __float_as_int(v), CTRL, 0xf, 0xf, true)); }
__device__ __forceinline__ float row16_max(float v) {
    v = fmaxf(v, dpp_mov<0xB1>(v)); v = fmaxf(v, dpp_mov<0x4E>(v)); v = fmaxf(v, dpp_mov<0x141>(v)); v = fmaxf(v, dpp_mov<0x140>(v)); return v; }
__device__ __forceinline__ float row16_sum(float v) {
    v += dpp_mov<0xB1>(v); v += dpp_mov<0x4E>(v); v += dpp_mov<0x141>(v); v += dpp_mov<0x140>(v); return v; }
__device__ __forceinline__ float xrow_sum(float v) {
    { auto r = __builtin_amdgcn_permlane16_swap(__float_as_uint(v), __float_as_uint(v), false, false); v = __uint_as_float(r[0]) + __uint_as_float(r[1]); }
    { auto r = __builtin_amdgcn_permlane32_swap(__float_as_uint(v), __float_as_uint(v), false, false); v = __uint_as_float(r[0]) + __uint_as_float(r[1]); }
    return v; }

template <int ACT  > struct EpiSplitBf16 {
    static constexpr bool PERM = true, AFTER_DRAIN = false; static constexpr int MID_T = 0;
    bf16_t* O; int ldc; int split_cols; size_t split_stride;
    __device__ __forceinline__ void operator()(const f32x4 (&acc)[2][2][4][2], const Unit& u, int wr, int wc, int fr, int fq) const {
        const int row0 = u.pm * BM + wr * 64 + fr; int colt = u.pn * BM; bf16_t* base = O;
        if (split_cols) { const int t = colt / split_cols; base += (size_t)t * split_stride; colt -= t * split_cols; }
        const int col0 = colt + wc * 32 + 8 * fq;
#pragma unroll
        for (int ai = 0; ai < 2; ++ai)
#pragma unroll
            for (int m = 0; m < 4; ++m) { bf16_t* rowp = base + (size_t)(row0 + ai * HALF + m * 16) * ldc + col0;
#pragma unroll
                for (int bj = 0; bj < 2; ++bj) { f32x4 v0 = acc[ai][bj][m][0], v1 = acc[ai][bj][m][1];
                    if (ACT == 1) { v0 = sigmoid4(v0); v1 = sigmoid4(v1); }
                    *(u32x4*)(rowp + bj * HALF) = pack8(v0, v1); } }
    }
};
struct EpiFoxQKV {
    static constexpr bool PERM = true, AFTER_DRAIN = false; static constexpr int MID_T = 0;
    bf16_t* O; unsigned* qn; unsigned* kn;
    __device__ __forceinline__ void operator()(const f32x4 (&acc)[2][2][4][2], const Unit& u, int wr, int wc, int fr, int fq) const {
        const int row0 = u.pm * BM + wr * 64 + fr, t = u.pn >> 2; bf16_t* base = O + (size_t)t * ((size_t)M * 1024);
        const int col0 = (u.pn & 3) * BM + wc * 32 + 8 * fq; float mx[2][2] = {{0.f, 0.f}, {0.f, 0.f}};
#pragma unroll
        for (int ai = 0; ai < 2; ++ai)
#pragma unroll
            for (int m = 0; m < 4; ++m) { bf16_t* rowp = base + (size_t)(row0 + ai * HALF + m * 16) * 1024 + col0;
#pragma unroll
                for (int bj = 0; bj < 2; ++bj) { const f32x4 v0 = acc[ai][bj][m][0], v1 = acc[ai][bj][m][1];
                    *(u32x4*)(rowp + bj * HALF) = pack8(v0, v1);
                    float s = (v0[0] * v0[0] + v0[1] * v0[1]) + (v0[2] * v0[2] + v0[3] * v0[3]) + (v1[0] * v1[0] + v1[1] * v1[1]) + (v1[2] * v1[2] + v1[3] * v1[3]);
                    s = xrow_sum(s);
                    mx[bj][ai] = fmaxf(mx[bj][ai], s); } }
        if (t < 2) {
#pragma unroll
            for (int bj = 0; bj < 2; ++bj)
#pragma unroll
                for (int ai = 0; ai < 2; ++ai) mx[bj][ai] = row16_max(mx[bj][ai]);
            if (fr == 0 && fq == 0) { const int b = u.pm >> 5, qb = u.pm & 31, h0 = 2 * (u.pn & 3);
#pragma unroll
                for (int bj = 0; bj < 2; ++bj) { const int bh = b * 8 + h0 + bj;
                    if (t == 0) __hip_atomic_fetch_max(qn + ((bh * 32 + qb) * 4 + wc), __float_as_uint(fmaxf(mx[bj][0], mx[bj][1])), __ATOMIC_RELAXED, __HIP_MEMORY_SCOPE_AGENT);
                    else {
#pragma unroll
                        for (int ai = 0; ai < 2; ++ai) __hip_atomic_fetch_max(kn + ((bh * 128 + qb * 4 + 2 * ai + wr) * 4 + wc), __float_as_uint(mx[bj][ai]), __ATOMIC_RELAXED, __HIP_MEMORY_SCOPE_AGENT); } } }
        }
    }
};
struct EpiSwiGLU {
    static constexpr bool PERM = true, AFTER_DRAIN = false; static constexpr int MID_T = 0;
    bf16_t* H; int ldc;
    __device__ __forceinline__ void operator()(const f32x4 (&acc)[2][2][4][2], const Unit& u, int wr, int wc, int fr, int fq) const {
        const int row0 = u.pm * BM + wr * 64 + fr, col0 = u.pn * HALF + wc * 32 + 8 * fq;
#pragma unroll
        for (int ai = 0; ai < 2; ++ai)
#pragma unroll
            for (int m = 0; m < 4; ++m) { const int row = row0 + ai * HALF + m * 16;
                bf16_t* rowp = H + ((size_t)(row >> 8) * (ldc >> 6) + (col0 >> 6)) * (size_t)(BM * BK) + (row & 255) * BK + (col0 & 63);
                const f32x4 a0 = acc[ai][0][m][0], a1 = acc[ai][0][m][1], b0 = acc[ai][1][m][0], b1 = acc[ai][1][m][1];
                const f32x4 v0 = a0 * sigmoid4(a0) * b0, v1 = a1 * sigmoid4(a1) * b1;
                *(u32x4*)rowp = pack8(v0, v1); }
    }
};
struct EpiRope {
    static constexpr bool PERM = true, AFTER_DRAIN = false; static constexpr int MID_T = 0;
    bf16_t* QB; bf16_t* KB; const float* cosT; const float* sinT;
    __device__ __forceinline__ void operator()(const f32x4 (&acc)[2][2][4][2], const Unit& u, int wr, int wc, int fr, int fq) const {
        const int row0 = u.pm * BM + wr * 64 + fr; const int tsel = u.pn / 6, pnl = u.pn - tsel * 6;
        bf16_t* base = tsel ? KB : QB; const int dd0 = 32 * (wc & 1) + 8 * fq, head = 2 * pnl + (wc >> 1);
#pragma unroll
        for (int ai = 0; ai < 2; ++ai)
#pragma unroll
            for (int m = 0; m < 4; ++m) { const int row = row0 + ai * HALF + m * 16, pos = row & (SEQ - 1);
                const f32x4 c0 = *(const f32x4*)(cosT + pos * 64 + dd0), c1 = *(const f32x4*)(cosT + pos * 64 + dd0 + 4);
                const f32x4 s0 = *(const f32x4*)(sinT + pos * 64 + dd0), s1 = *(const f32x4*)(sinT + pos * 64 + dd0 + 4);
                const f32x4 x10 = acc[ai][0][m][0], x11 = acc[ai][0][m][1], x20 = acc[ai][1][m][0], x21 = acc[ai][1][m][1];
                bf16_t* rowp = base + (size_t)row * 1536 + head * 128 + dd0;
                *(u32x4*)rowp = pack8(x10 * c0 - x20 * s0, x11 * c1 - x21 * s1);
                *(u32x4*)(rowp + 64) = pack8(x20 * c0 + x10 * s0, x21 * c1 + x11 * s1);
                asm volatile("" ::: "memory"); }
    }
};
template <int MODE> struct EpiGate {
    static constexpr bool PERM = true, AFTER_DRAIN = false; static constexpr int MID_T = 0;
    const bf16_t* G; bf16_t* T;
    __device__ __forceinline__ void operator()(const f32x4 (&acc)[2][2][4][2], const Unit& u, int wr, int wc, int fr, int fq) const {
        const int row0 = u.pm * BM + wr * 64 + fr, col0 = u.pn * BM + wc * 32 + 8 * fq;
#pragma unroll
        for (int ai = 0; ai < 2; ++ai)
#pragma unroll
            for (int m = 0; m < 4; ++m) { const size_t off = (size_t)(row0 + ai * HALF + m * 16) * 2048 + col0;
#pragma unroll
                for (int bj = 0; bj < 2; ++bj) { f32x4 g0, g1; unpack8(*(const u32x4*)(G + off + bj * HALF), g0, g1);
                    f32x4 v0 = g0 * acc[ai][bj][m][0], v1 = g1 * acc[ai][bj][m][1];
                    if (MODE == 1) { f32x4 t0, t1; unpack8(*(const u32x4*)(T + off + bj * HALF), t0, t1); v0 += t0; v1 += t1; }
                    *(u32x4*)(T + off + bj * HALF) = pack8(v0, v1); }
                asm volatile("" ::: "memory"); }
    }
};
struct EpiGates {
    static constexpr bool PERM = true, AFTER_DRAIN = false; static constexpr int MID_T = 0;
    bf16_t* R; bf16_t* GB;
    __device__ __forceinline__ void operator()(const f32x4 (&acc)[2][2][4][2], const Unit& u, int wr, int wc, int fr, int fq) const {
        const int row0 = u.pm * BM + wr * 64 + fr, col0 = u.pn * HALF + wc * 32 + 8 * fq;
#pragma unroll
        for (int ai = 0; ai < 2; ++ai)
#pragma unroll
            for (int m = 0; m < 4; ++m) { const size_t off = (size_t)(row0 + ai * HALF + m * 16) * 2048 + col0; f32x4 r[2], g[2];
#pragma unroll
                for (int n = 0; n < 2; ++n)
#pragma unroll
                    for (int e_ = 0; e_ < 4; ++e_) { const float ea = __builtin_amdgcn_exp2f(-1.4426950408889634f * acc[ai][0][m][n][e_]), eb = __builtin_amdgcn_exp2f(-1.4426950408889634f * acc[ai][1][m][n][e_]);
                        g[n][e_] = __builtin_amdgcn_rcpf(1.0f + eb); r[n][e_] = (1.0f + eb) * __builtin_amdgcn_rcpf(1.0f + ea); }
                *(u32x4*)(R + off) = pack8(r[0], r[1]); *(u32x4*)(GB + off) = pack8(g[0], g[1]); }
    }
};
struct EpiMixOut {
    static constexpr bool PERM = true, AFTER_DRAIN = false; static constexpr int MID_T = 16;
    const bf16_t* GA; const bf16_t* GB; bf16_t* T;
    __device__ __forceinline__ void mid(f32x4 (&acc)[2][2][4][2], const Unit& u, int wr, int wc, int fr, int fq) const {
        const int row0 = u.pm * BM + wr * 64 + fr, col0 = u.pn * BM + wc * 32 + 8 * fq;
        u32x4 r[2][4][2];
#pragma unroll
        for (int ai = 0; ai < 2; ++ai)
#pragma unroll
            for (int m = 0; m < 4; ++m) { const size_t off = (size_t)(row0 + ai * HALF + m * 16) * 2048 + col0;
#pragma unroll
                for (int bj = 0; bj < 2; ++bj) r[ai][m][bj] = *(const u32x4*)(GA + off + bj * HALF); }
#pragma unroll
        for (int ai = 0; ai < 2; ++ai)
#pragma unroll
            for (int m = 0; m < 4; ++m)
#pragma unroll
                for (int bj = 0; bj < 2; ++bj) { f32x4 a0, a1; unpack8(r[ai][m][bj], a0, a1); acc[ai][bj][m][0] *= a0; acc[ai][bj][m][1] *= a1; }
    }
    __device__ __forceinline__ void operator()(const f32x4 (&acc)[2][2][4][2], const Unit& u, int wr, int wc, int fr, int fq) const {
        const int row0 = u.pm * BM + wr * 64 + fr, col0 = u.pn * BM + wc * 32 + 8 * fq;
u32x4 r[2][4][2];
#pragma unroll
        for (int ai = 0; ai < 2; ++ai)
#pragma unroll
            for (int m = 0; m < 4; ++m) { const size_t off = (size_t)(row0 + ai * HALF + m * 16) * 2048 + col0;
#pragma unroll
                for (int bj = 0; bj < 2; ++bj) r[ai][m][bj] = *(const u32x4*)(GB + off + bj * HALF); }
#pragma unroll
        for (int ai = 0; ai < 2; ++ai)
#pragma unroll
            for (int m = 0; m < 4; ++m) { const size_t off = (size_t)(row0 + ai * HALF + m * 16) * 2048 + col0;
#pragma unroll
                for (int bj = 0; bj < 2; ++bj) { f32x4 b0, b1; unpack8(r[ai][m][bj], b0, b1);
                    *(u32x4*)(T + off + bj * HALF) = pack8(acc[ai][bj][m][0] * b0, acc[ai][bj][m][1] * b1); } }
    }
};
struct EpiPle {
    static constexpr bool PERM = true, AFTER_DRAIN = false; static constexpr int MID_T = 0;
    const bf16_t* E; bf16_t* O;
    __device__ __forceinline__ void operator()(const f32x4 (&acc)[2][2][4][2], const Unit& u, int wr, int wc, int fr, int fq) const {
        const int row0 = u.pm * BM + wr * 64 + fr, col0 = u.pn * BM + wc * 32 + 8 * fq;
u32x4 r[2][4][2];
#pragma unroll
        for (int ai = 0; ai < 2; ++ai)
#pragma unroll
            for (int m = 0; m < 4; ++m) { const size_t off = (size_t)(row0 + ai * HALF + m * 16) * 2048 + col0;
#pragma unroll
                for (int bj = 0; bj < 2; ++bj) r[ai][m][bj] = *(const u32x4*)(E + off + bj * HALF); }
#pragma unroll
        for (int ai = 0; ai < 2; ++ai)
#pragma unroll
            for (int m = 0; m < 4; ++m) { const size_t off = (size_t)(row0 + ai * HALF + m * 16) * 2048 + col0;
#pragma unroll
                for (int bj = 0; bj < 2; ++bj) { f32x4 e0, e1; unpack8(r[ai][m][bj], e0, e1);
                    *(u32x4*)(O + off + bj * HALF) = pack8(sigmoid4(acc[ai][bj][m][0]) * e0, sigmoid4(acc[ai][bj][m][1]) * e1); } }
    }
};
template <int MODE> struct EpiF32 {
    static constexpr bool PERM = false, AFTER_DRAIN = false; static constexpr int MID_T = 0;
    float* C; int ldc;
    __device__ __forceinline__ void operator()(const f32x4 (&acc)[2][2][4][2], const Unit& u, int wr, int wc, int fr, int fq) const {
        const int row0 = u.pm * BM + wr * 64 + fr, col0 = u.pn * BM + wc * 32 + 4 * fq;
#pragma unroll
        for (int ai = 0; ai < 2; ++ai)
#pragma unroll
            for (int m = 0; m < 4; ++m) { float* rowp = C + (size_t)(row0 + ai * HALF + m * 16) * ldc + col0;
#pragma unroll
                for (int bj = 0; bj < 2; ++bj) {
#pragma unroll
                    for (int n = 0; n < 2; ++n) { f32x4 v = acc[ai][bj][m][n];
                        if (MODE == 1) { v = sigmoid4(v) * *(const f32x4*)(rowp + bj * HALF + n * 16); }
                        *(f32x4*)(rowp + bj * HALF + n * 16) = v; }
                    if (MODE == 1) asm volatile("" ::: "memory"); } }
    }
};

template <class Epi, class Sched, bool ALIGN_EPI = false, bool SP2 = false>
__device__ __forceinline__ void gemm_phase(PG8_LAS unsigned char* lds, const Gemm g, const Sched& S, const Epi& E) {
    const int tid_ = g.wave * 64 + lane_id_now();
    const int tid = tid_, wid = __builtin_amdgcn_readfirstlane(g.wave), lane = tid & 63, wr = wid >> 2, wc = wid & 3, fr = lane & 15, fq = lane >> 4;
    __builtin_amdgcn_s_waitcnt(0);
    const int K = g.K, nt = K / BK;
    unsigned voffA[2], voffB[2];
#pragma unroll
    for (int i = 0; i < 2; ++i) { int R, C; stage_rc(tid * 16 + i * 8192, R, C); const int Rb = Epi::PERM ? ((R & ~31) + perm32(R & 31)) : R;
        voffA[i] = (unsigned)(R * (g.a_tiled ? BK : K) + C) * 2u; voffB[i] = (unsigned)(Rb * K + C) * 2u; }
    const size_t kstep = (size_t)(BK * 2);
    const size_t hstep = (size_t)HALF * K * 2;
    const size_t tstep = 2 * hstep;
    const size_t kstepA = g.a_tiled ? (size_t)(BM * BK * 2) : kstep, hstepA = g.a_tiled ? (size_t)(HALF * BK * 2) : hstep;
    const unsigned ldsw = (unsigned)wid * 1024u;
    const int aoff = lds_byte(wr * 64 + fr, fq * 8), boff = lds_byte(wc * 32 + fr, fq * 8);
#define PG8_SA(b, h) (((b) * 2 + (h)) * HTB)
#define PG8_SB(b, h) ((4 + (b) * 2 + (h)) * HTB)
#define PG8_STAGE(bufoff, gbase, voff) do { _Pragma("unroll") for (int _i = 0; _i < 2; ++_i) \
        __builtin_amdgcn_global_load_lds((const unsigned*)((const char*)(gbase) + (voff)[_i]), (PG8_LAS unsigned*)(lds + (bufoff) + ldsw + _i * 8192), 16, 0, 0); } while (0)
#define PG8_LDA(dst, b, h) do { _Pragma("unroll") for (int m = 0; m < 4; ++m) _Pragma("unroll") for (int k = 0; k < 2; ++k) dst[m][k] = *(const PG8_LAS bf16x8*)(lds + PG8_SA(b, h) + aoff + m * 2048 + k * 1024); } while (0)
#define PG8_LDB(dst, b, h) do { _Pragma("unroll") for (int n = 0; n < 2; ++n) _Pragma("unroll") for (int k = 0; k < 2; ++k) dst[n][k] = *(const PG8_LAS bf16x8*)(lds + PG8_SB(b, h) + boff + n * 2048 + k * 1024); } while (0)
#define PG8_MMA(ai, bj, At, Bt) do { __builtin_amdgcn_s_setprio(1); _Pragma("unroll") for (int m = 0; m < 4; ++m) _Pragma("unroll") for (int n = 0; n < 2; ++n) _Pragma("unroll") for (int k = 0; k < 2; ++k) \
        acc[ai][bj][m][n] = __builtin_amdgcn_mfma_f32_16x16x32_bf16(Bt[n][k], At[m][k], acc[ai][bj][m][n], 0, 0, 0); __builtin_amdgcn_s_setprio(0); } while (0)
#define PG8_WAIT_V(n) asm volatile("s_waitcnt vmcnt(" #n ")" ::: "memory")
#define PG8_WAIT_L(n) asm volatile("s_waitcnt lgkmcnt(" #n ")" ::: "memory")
#define PG8_BAR __builtin_amdgcn_s_barrier()
#define PG8_SCHED __builtin_amdgcn_sched_barrier(0)
    Unit cur, nxt; int ui = 0;
    if (!S.next(0, cur)) return;
    f32x4 acc[2][2][4][2];
#pragma unroll
    for (int a = 0; a < 2; ++a)
#pragma unroll
        for (int b = 0; b < 2; ++b)
#pragma unroll
            for (int m = 0; m < 4; ++m)
#pragma unroll
                for (int n = 0; n < 2; ++n) acc[a][b][m][n] = (f32x4){0.f, 0.f, 0.f, 0.f};
    bf16x8 At[4][2], B0[2][2], B1[2][2];
    const char* cA = (const char*)g.A + (size_t)cur.pm * tstep; const char* cB = (const char*)g.Bt + (size_t)cur.pn * tstep;
    S.a_ready(cur);
    if constexpr (SP2) {
        PG8_STAGE(PG8_SB(0, 0), cB, voffB); PG8_STAGE(PG8_SB(0, 1), cB + hstep, voffB); PG8_STAGE(PG8_SA(0, 0), cA, voffA); PG8_STAGE(PG8_SA(0, 1), cA + hstepA, voffA);
        if (wr == 1) PG8_BAR;
        PG8_WAIT_V(2); PG8_BAR;
        PG8_STAGE(PG8_SB(1, 0), cB + kstep, voffB); PG8_STAGE(PG8_SA(1, 0), cA + kstepA, voffA); PG8_STAGE(PG8_SB(1, 1), cB + hstep + kstep, voffB);
        PG8_WAIT_V(6); PG8_BAR;
    } else {
        PG8_STAGE(PG8_SB(0, 0), cB, voffB); PG8_STAGE(PG8_SA(0, 0), cA, voffA); PG8_STAGE(PG8_SB(0, 1), cB + hstep, voffB); PG8_STAGE(PG8_SA(0, 1), cA + hstepA, voffA);
        if (wr == 1) PG8_BAR;
        PG8_WAIT_V(4); PG8_BAR;
        PG8_STAGE(PG8_SB(1, 0), cB + kstep, voffB); PG8_STAGE(PG8_SA(1, 0), cA + kstepA, voffA); PG8_STAGE(PG8_SB(1, 1), cB + hstep + kstep, voffB);
        PG8_WAIT_V(6); PG8_BAR;
    }
    for (;;) {
        const bool has_next = S.next(ui + 1, nxt);
        const char* nA = has_next ? (const char*)g.A + (size_t)nxt.pm * tstep : cA; const char* nB = has_next ? (const char*)g.Bt + (size_t)nxt.pn * tstep : cB;
        for (int t = 0; t < nt; t += 2) {
            const bool last = (t == nt - 2);
            const char* a1 = cA + (size_t)(t + 1) * kstepA;
            const char* a2 = last ? nA : cA + (size_t)(t + 2) * kstepA; const char* b2 = last ? nB : cB + (size_t)(t + 2) * kstep;
            const char* a3 = a2 + kstepA; const char* b3 = b2 + kstep;
            if (last && has_next) S.a_ready(nxt);
            if constexpr (Epi::MID_T > 0) { if (t == Epi::MID_T) {
                const int l_ = lane_id_now(); E.mid(acc, cur, wr, wc, l_ & 15, l_ >> 4); } }
            if constexpr (SP2) {
            PG8_LDB(B0, 0, 0); PG8_LDB(B1, 0, 1); PG8_SCHED; PG8_LDA(At, 0, 0); PG8_STAGE(PG8_SA(1, 1), a1 + hstepA, voffA);
            PG8_WAIT_V(8); PG8_WAIT_L(0); PG8_BAR; PG8_MMA(0, 0, At, B0); PG8_MMA(0, 1, At, B1); PG8_BAR; PG8_SCHED;
            PG8_LDA(At, 0, 1); PG8_STAGE(PG8_SB(0, 0), b2, voffB); PG8_STAGE(PG8_SB(0, 1), b2 + hstep, voffB); PG8_STAGE(PG8_SA(0, 0), a2, voffA);
            PG8_WAIT_V(8); PG8_WAIT_L(0); PG8_BAR; PG8_MMA(1, 0, At, B0); PG8_MMA(1, 1, At, B1); PG8_BAR; PG8_SCHED;
            PG8_LDB(B0, 1, 0); PG8_LDB(B1, 1, 1); PG8_SCHED; PG8_LDA(At, 1, 0); PG8_STAGE(PG8_SA(0, 1), a2 + hstepA, voffA);
            PG8_WAIT_V(8); PG8_WAIT_L(0); PG8_BAR; PG8_MMA(0, 0, At, B0); PG8_MMA(0, 1, At, B1); PG8_BAR; PG8_SCHED;
            PG8_LDA(At, 1, 1); PG8_STAGE(PG8_SB(1, 0), b3, voffB); PG8_STAGE(PG8_SB(1, 1), b3 + hstep, voffB); PG8_STAGE(PG8_SA(1, 0), a3, voffA);
            PG8_WAIT_V(8); PG8_WAIT_L(0); PG8_BAR; PG8_MMA(1, 0, At, B0); PG8_MMA(1, 1, At, B1); PG8_BAR; PG8_SCHED;
            } else {
            PG8_LDB(B0, 0, 0); PG8_SCHED; PG8_LDA(At, 0, 0); PG8_STAGE(PG8_SA(1, 1), a1 + hstepA, voffA);
            PG8_WAIT_L(8); PG8_BAR; PG8_WAIT_L(0); PG8_MMA(0, 0, At, B0); PG8_BAR; PG8_SCHED;
            PG8_LDB(B1, 0, 1); PG8_STAGE(PG8_SB(0, 0), b2, voffB);
            PG8_BAR; PG8_WAIT_L(0); PG8_MMA(0, 1, At, B1); PG8_BAR;
            PG8_LDA(At, 0, 1); PG8_STAGE(PG8_SA(0, 0), a2, voffA);
            PG8_BAR; PG8_WAIT_L(0); PG8_MMA(1, 0, At, B0); PG8_BAR; PG8_SCHED;
            PG8_STAGE(PG8_SB(0, 1), b2 + hstep, voffB);
            PG8_WAIT_V(6); PG8_BAR; PG8_MMA(1, 1, At, B1); PG8_BAR;
            PG8_LDB(B0, 1, 0); PG8_SCHED; PG8_LDA(At, 1, 0); PG8_STAGE(PG8_SA(0, 1), a2 + hstepA, voffA);
            PG8_WAIT_L(8); PG8_BAR; PG8_WAIT_L(0); PG8_MMA(0, 0, At, B0); PG8_BAR; PG8_SCHED;
            PG8_LDB(B1, 1, 1); PG8_STAGE(PG8_SB(1, 0), b3, voffB);
            PG8_BAR; PG8_WAIT_L(0); PG8_MMA(0, 1, At, B1); PG8_BAR;
            PG8_LDA(At, 1, 1); PG8_STAGE(PG8_SA(1, 0), a3, voffA);
            PG8_BAR; PG8_WAIT_L(0); PG8_MMA(1, 0, At, B0); PG8_BAR; PG8_SCHED;
            PG8_STAGE(PG8_SB(1, 1), b3 + hstep, voffB);
            PG8_WAIT_V(6); PG8_BAR; PG8_MMA(1, 1, At, B1); PG8_BAR;
            }
        }
        if constexpr (ALIGN_EPI) { if (wr == 0) PG8_BAR; }
        if constexpr (!Epi::AFTER_DRAIN) { const int l_ = lane_id_now();
            E(acc, cur, wr, wc, l_ & 15, l_ >> 4); S.done(cur); }
        if (!has_next) break;
#pragma unroll
        for (int a = 0; a < 2; ++a)
#pragma unroll
            for (int b = 0; b < 2; ++b)
#pragma unroll
                for (int m = 0; m < 4; ++m)
#pragma unroll
                    for (int n = 0; n < 2; ++n) acc[a][b][m][n] = (f32x4){0.f, 0.f, 0.f, 0.f};
        cur = nxt; cA = nA; cB = nB; ++ui;
        if constexpr (ALIGN_EPI) { if (wr == 1) PG8_BAR; }
    }
    PG8_WAIT_V(0);
    if constexpr (!ALIGN_EPI) { if (wr == 0) PG8_BAR; }
    PG8_BAR;
    if constexpr (Epi::AFTER_DRAIN) { E.fused(acc, cur, wr, wc, fr, fq, lds, wid, lane); S.done(cur); }
#undef PG8_SA
#undef PG8_SB
#undef PG8_STAGE
#undef PG8_LDA
#undef PG8_LDB
#undef PG8_MMA
#undef PG8_WAIT_V
#undef PG8_WAIT_L
#undef PG8_BAR
#undef PG8_SCHED
}
}
#define GAS __attribute__((address_space(1)))
#define LAS __attribute__((address_space(3)))
typedef unsigned short bf16;
typedef unsigned v4u __attribute__((ext_vector_type(4)));
typedef float f32x4 __attribute__((ext_vector_type(4)));
typedef short bf16x8 __attribute__((ext_vector_type(8)));
typedef GAS unsigned gu32;
typedef GAS unsigned long long gu64;
#define RLX_AGENT __ATOMIC_RELAXED, __HIP_MEMORY_SCOPE_AGENT
#define LDS_WAIT() asm volatile("s_waitcnt lgkmcnt(0)" ::: "memory")
#define VM_WAIT() asm volatile("s_waitcnt vmcnt(0)" ::: "memory")
__device__ __forceinline__ unsigned long long rt() { return __builtin_amdgcn_s_memrealtime(); }
__device__ __forceinline__ unsigned f2bf(float f) { unsigned u = __builtin_bit_cast(unsigned, f); return (u + 0x7fffu + ((u >> 16) & 1u)) >> 16; }
__device__ __forceinline__ unsigned pk2(float lo, float hi) { return f2bf(lo) | (f2bf(hi) << 16); }

#define XB_TMO      128
#define XB_XCNT(j)  (256  + 64 * (j))
#define XB_XSUB(j)  (1280 + 64 * (j))
#define XB_XGEN(j)  (2304 + 64 * (j))
#define XB_TOP      3328
#define XB_TOPGEN   3392
#define XCD_BAR_WORDS 3456
#define XB_SPIN_CAP (1u << 18)

__device__ __forceinline__ unsigned xb_ld(unsigned* p)              { return __hip_atomic_load(p, __ATOMIC_RELAXED, __HIP_MEMORY_SCOPE_AGENT); }
__device__ __forceinline__ unsigned xb_add(unsigned* p, unsigned v) { return __hip_atomic_fetch_add(p, v, __ATOMIC_RELAXED, __HIP_MEMORY_SCOPE_AGENT); }
__device__ __forceinline__ unsigned xb_xcc_id() { return (unsigned)__builtin_amdgcn_s_getreg((3 << 11) | 20) & 0xFu; }
#define XB_SPIN(cond, bar) do { unsigned _sp = 0; while (cond) { __builtin_amdgcn_s_sleep(1); \
    if ((++_sp & 255u) == 0u) { if (xb_ld(&(bar)[XB_TMO])) break; if (_sp > XB_SPIN_CAP) { atomicAdd(&(bar)[XB_TMO], 1u); break; } } } } while (0)

struct XcdBarrier {
    unsigned* bar; unsigned x; int wave;
    volatile LAS unsigned* st;
};

__device__ __forceinline__ XcdBarrier xcd_barrier_post(unsigned* bar, volatile LAS unsigned* st) {
    XcdBarrier b; b.bar = bar; b.x = xb_xcc_id(); b.st = st;
    if (threadIdx.x == 0) (void)xb_add(&bar[XB_XCNT(b.x)], 1u);
    return b;
}
__device__ __forceinline__ void xcd_barrier_complete(unsigned* bar, unsigned x, unsigned& nloc, unsigned& nx) {
    const unsigned G = gridDim.x * gridDim.y * gridDim.z;
    unsigned sum, cnt, mine, sp = 0u;
    for (;;) {
        sum = 0u; cnt = 0u; mine = 0u;
#pragma unroll
        for (unsigned j = 0; j < 16; ++j) { const unsigned c = xb_ld(&bar[XB_XCNT(j)]); sum += c; cnt += (c > 0u) ? 1u : 0u; mine = (j == x) ? c : mine; }
        if (sum == G) break;
        __builtin_amdgcn_s_sleep(1);
        if ((++sp & 255u) == 0u) { if (xb_ld(&bar[XB_TMO])) break; if (sp > XB_SPIN_CAP) { atomicAdd(&bar[XB_TMO], 1u); break; } }
    }
    nloc = mine > 0u ? mine : 1u; nx = cnt > 0u ? cnt : 1u;
}

__device__ __forceinline__ void xcd_barrier(const XcdBarrier& b) {
    asm volatile("s_waitcnt vmcnt(0)" ::: "memory");
    __syncthreads();
    const int t0_ = b.wave * 64 + pg8::lane_id_now();
    if (t0_ == 0) {
        size_t zb_ = 0; unsigned bx_ = b.x; asm volatile("" : "+s"(zb_), "+s"(bx_)); unsigned* bar = b.bar + zb_;
        __builtin_amdgcn_s_waitcnt(0);
        unsigned nloc = b.st[0], nx = b.st[1];
        if (nloc == 0u) { xcd_barrier_complete(bar, bx_, nloc, nx); b.st[0] = nloc; b.st[1] = nx; }
        const unsigned old = xb_add(&bar[XB_XSUB(bx_)], 1u);
        const unsigned gen = old / nloc;
        if (old + 1u == (gen + 1u) * nloc) {
            __builtin_amdgcn_fence(__ATOMIC_RELEASE, "agent");
            asm volatile("s_waitcnt vmcnt(0)" ::: "memory");
            const unsigned og = xb_add(&bar[XB_TOP], 1u);
            const unsigned tg = og / nx;
            if (og + 1u == (tg + 1u) * nx) xb_add(&bar[XB_TOPGEN], 1u);
            else XB_SPIN(xb_ld(&bar[XB_TOPGEN]) == tg, bar);
            __builtin_amdgcn_fence(__ATOMIC_ACQUIRE, "agent");
            xb_add(&bar[XB_XGEN(bx_)], 1u);
            asm volatile("s_waitcnt vmcnt(0)" ::: "memory");
        } else {
            XB_SPIN(xb_ld(&bar[XB_XGEN(bx_)]) == gen, bar);
            __builtin_amdgcn_fence(__ATOMIC_ACQUIRE, "agent");
            asm volatile("s_waitcnt vmcnt(0)" ::: "memory");
        }
    }
    __syncthreads();
}
#ifndef MK_NAIVE_ATTN
#define MK_NAIVE_ATTN 0
#endif
namespace att {
typedef short bf16x8 __attribute__((ext_vector_type(8)));
typedef short s16x4 __attribute__((ext_vector_type(4)));
typedef float f32x16 __attribute__((ext_vector_type(16)));
constexpr float SCALE = 0.08838834764831845f, LOG2E = 1.4426950408889634f, THR = 8.f;
constexpr int D = 128, NW = 8, QBLK = 32, KVBLK = 64, QB = NW * QBLK;
constexpr int SHM_V = KVBLK * D * 2, SHM_K = KVBLK * D * 2;
constexpr int OFF_WS = 2 * SHM_V + 2 * SHM_K, OFF_BIAS = OFF_WS + NW * 64 * 4, OFF_QSLOT = OFF_BIAS + 2 * 64 * 4, ATT_LDS_BYTES = OFF_QSLOT + 16;
#define KSWZ(row, colB) ((row) * 256 + ((colB) ^ (((row) & 7) << 4)))
#define SBAR() __builtin_amdgcn_sched_barrier(0)
__device__ __forceinline__ int v_st(int k, int c) { const int kk = (k & ~0xC) | ((k & 4) << 1) | ((k & 8) >> 1); return ((kk >> 3) * 4 + (c >> 5)) * 512 + ((kk & 7) * 32 + (c & 31)) * 2; }
__device__ __forceinline__ int v_rd_base(int lane) { return ((lane & 3) << 3) | (((lane >> 2) & 3) << 6) | (((lane >> 4) & 1) << 5) | (((lane >> 5) & 1) << 8); }
constexpr int v_rd_off(int d0, int ks, int half) { return d0 * 512 + ks * 4096 + half * 2048; }
__device__ __forceinline__ int crow(int r, int hi) { return (r & 3) + 8 * (r >> 2) + 4 * hi; }
__device__ __forceinline__ unsigned cvtpk(float lo, float hi) { return pg8::cvt_pk_bf16(lo, hi); }
__device__ __forceinline__ bf16x8 load8(const bf16* p) { return *reinterpret_cast<const bf16x8*>(p); }
__device__ __forceinline__ void mask_tile(f32x16& p0, f32x16& p1, int dq, unsigned W) {
    const float NEG = -__builtin_inff();
#pragma unroll
    for (int r = 0; r < 16; ++r) {
        const int c = (r & 3) + 8 * (r >> 2);
        if ((unsigned)(dq - c) >= W) p0[r] = NEG;
        if ((unsigned)(dq - c - 32) >= W) p1[r] = NEG;
    }
}
template <bool FOX>
__device__ __forceinline__ void partialSM(f32x16& p0, f32x16& p1, float& m_reg, float& mn, float& alpha) {
    constexpr float C2 = LOG2E * SCALE;
    float pmax = p0[0]; for (int r = 1; r < 16; ++r) pmax = fmaxf(pmax, p0[r]); for (int r = 0; r < 16; ++r) pmax = fmaxf(pmax, p1[r]);
    { auto rr = __builtin_amdgcn_permlane32_swap(__float_as_uint(pmax), __float_as_uint(pmax), false, false);
      pmax = fmaxf(__uint_as_float(rr[0]), __uint_as_float(rr[1])); }
    if (__builtin_expect(__all((pmax - m_reg) * SCALE <= THR), 1)) { mn = m_reg; alpha = 1.f; }
    else { mn = fmaxf(m_reg, pmax); alpha = __builtin_amdgcn_exp2f((m_reg - mn) * C2); m_reg = mn; }
    const float mnL = -mn * C2;
    for (int r = 0; r < 16; ++r) p0[r] = fmaf(p0[r], C2, mnL); for (int r = 0; r < 16; ++r) p1[r] = fmaf(p1[r], C2, mnL);
    for (int r = 0; r < 16; ++r) p0[r] = __builtin_amdgcn_exp2f(p0[r]);
}
__device__ __forceinline__ void finishSM(f32x16& p0, f32x16& p1, float alpha, float& l_reg, bf16x8& pa0, bf16x8& pa1, bf16x8& pa2, bf16x8& pa3) {
    for (int r = 0; r < 16; ++r) p1[r] = __builtin_amdgcn_exp2f(p1[r]);
    float ps = 0; for (int r = 0; r < 16; ++r) ps += p0[r]; for (int r = 0; r < 16; ++r) ps += p1[r];
    { auto rr = __builtin_amdgcn_permlane32_swap(__float_as_uint(ps), __float_as_uint(ps), false, false);
      ps = __uint_as_float(rr[0]) + __uint_as_float(rr[1]); }
    l_reg = l_reg * alpha + ps;
#define PK4(P, B_, OUT) do { unsigned a0 = cvtpk(P[B_+0], P[B_+1]), a1 = cvtpk(P[B_+2], P[B_+3]);                          \
        unsigned b0 = cvtpk(P[B_+4], P[B_+5]), b1 = cvtpk(P[B_+6], P[B_+7]);                                             \
        auto r0 = __builtin_amdgcn_permlane32_swap(a0, b0, false, false); auto r1 = __builtin_amdgcn_permlane32_swap(a1, b1, false, false); \
        v4u w = {r0[0], r1[0], r0[1], r1[1]}; OUT = *reinterpret_cast<bf16x8*>(&w); } while (0)
    PK4(p0, 0, pa0); PK4(p0, 8, pa1); PK4(p1, 0, pa2); PK4(p1, 8, pa3);
#undef PK4
}
template <int KB, bool SK, bool FOX>
__device__ __forceinline__ void qkt(f32x16& p0, f32x16& p1, const char* K_lds, int r32, int hi, const bf16x8* qr, bool act, const float* bias) {
    if (SK && !act) { const float NEG = -__builtin_inff();
#pragma unroll
        for (int r = 0; r < 16; ++r) { p0[r] = NEG; p1[r] = NEG; } return; }
    if constexpr (FOX) {
#pragma unroll
        for (int g = 0; g < 4; ++g) { const f32x4 b0 = *(const f32x4*)(bias + KB * 64 + 8 * g + 4 * hi), b1 = *(const f32x4*)(bias + KB * 64 + 32 + 8 * g + 4 * hi);
#pragma unroll
            for (int e = 0; e < 4; ++e) { p0[4 * g + e] = b0[e]; p1[4 * g + e] = b1[e]; } }
    } else { p0 = f32x16{}; p1 = f32x16{}; }
    const char* kb[4];
#pragma unroll
    for (int dd = 0; dd < 4; ++dd) kb[dd] = K_lds + KB * SHM_K + KSWZ(r32, (dd * 16 + hi * 8) * 2);
#pragma unroll
    for (int d0 = 0; d0 < 8; ++d0) { const char* a = kb[d0 & 3] + (d0 >> 2) * 128;
        bf16x8 b0 = *reinterpret_cast<const bf16x8*>(a);
        bf16x8 b1 = *reinterpret_cast<const bf16x8*>(a + 32 * 256);
        p0 = __builtin_amdgcn_mfma_f32_32x32x16_bf16(b0, qr[d0], p0, 0, 0, 0);
        p1 = __builtin_amdgcn_mfma_f32_32x32x16_bf16(b1, qr[d0], p1, 0, 0, 0); }
}
template <int VB, bool SK>
__device__ __forceinline__ void pv_tile(f32x16* o, int vb0, bf16x8 pa0, bf16x8 pa1, bf16x8 pa2, bf16x8 pa3, bool act) {
    if (SK && !act) return;
#define TRRD(dst, off) asm volatile("ds_read_b64_tr_b16 %0, %1 offset:%2" : "=&v"(dst) : "v"(vb0), "i"(off) : "memory")
#define PV_D0(d0) do { s16x4 l0, l1, l2, l3, h0, h1, h2, h3; constexpr int b_ = VB * SHM_V + v_rd_off(d0, 0, 0);   \
        TRRD(l0, b_); TRRD(h0, b_ + 2048); TRRD(l1, b_ + 4096); TRRD(h1, b_ + 6144); TRRD(l2, b_ + 8192); TRRD(h2, b_ + 10240); TRRD(l3, b_ + 12288); TRRD(h3, b_ + 14336); \
        asm volatile("s_waitcnt lgkmcnt(0)" ::: "memory"); SBAR();                                                          \
        o[d0] = __builtin_amdgcn_mfma_f32_32x32x16_bf16(pa0, (bf16x8){l0[0], l0[1], l0[2], l0[3], h0[0], h0[1], h0[2], h0[3]}, o[d0], 0, 0, 0);   \
        o[d0] = __builtin_amdgcn_mfma_f32_32x32x16_bf16(pa1, (bf16x8){l1[0], l1[1], l1[2], l1[3], h1[0], h1[1], h1[2], h1[3]}, o[d0], 0, 0, 0);   \
        o[d0] = __builtin_amdgcn_mfma_f32_32x32x16_bf16(pa2, (bf16x8){l2[0], l2[1], l2[2], l2[3], h2[0], h2[1], h2[2], h2[3]}, o[d0], 0, 0, 0);   \
        o[d0] = __builtin_amdgcn_mfma_f32_32x32x16_bf16(pa3, (bf16x8){l3[0], l3[1], l3[2], l3[3], h3[0], h3[1], h3[2], h3[3]}, o[d0], 0, 0, 0); } while (0)
    PV_D0(0); PV_D0(1); PV_D0(2); PV_D0(3);
#undef PV_D0
#undef TRRD
}
struct BlockRef { const bf16* Q; const bf16* K; const bf16* V; bf16* O; const float* cum; float* lse; int P0, ld, ldo, lse_stride, skv, jlo; };
struct Seam { bf16x8 qr[8]; bf16x8 st_v0, st_v1, st_k0, st_k1; float st_b; int wave; };
__device__ __forceinline__ int swa_jlo(int P0, int W) { const int lowk = P0 - W + 1; return lowk > 0 ? lowk / KVBLK : 0; }
#define VMW() asm volatile("s_waitcnt vmcnt(0)" ::: "memory")
#define VMWN(n) asm volatile("s_waitcnt vmcnt(%0)" :: "i"(n) : "memory")
#define SLOAD_H(B_, k0) do { const bf16* vt_ = (B_).V + (size_t)(k0) * (B_).ld; const bf16* kt_ = (B_).K + (size_t)(k0) * (B_).ld;         \
                             const int o0_ = sr * (B_).ld + sc, o1_ = o0_ + 32 * (B_).ld;                                                     \
                             S.st_v0 = load8(vt_ + o0_); S.st_v1 = load8(vt_ + o1_); S.st_k0 = load8(kt_ + o0_); S.st_k1 = load8(kt_ + o1_);   \
                             if constexpr (FOX) { if (tid < 64) S.st_b = (B_).cum[(k0) + tid]; } } while (0)
#define SWRITE_HK(bf, cref_) do { *(bf16x8*)(K_lds + (bf) * SHM_K + kws) = S.st_k0; *(bf16x8*)(K_lds + (bf) * SHM_K + kws + 32 * 256) = S.st_k1;      \
                                  if constexpr (FOX) { if (tid < 64) bias_l[(bf) * 64 + tid] = ((cref_) - S.st_b) * (1.0f / SCALE); } } while (0)
#define SWRITE_HV(bf) do { *(bf16x8*)(V_lds + (bf) * SHM_V + vst0) = S.st_v0; *(bf16x8*)(V_lds + (bf) * SHM_V + vst1) = S.st_v1; } while (0)
#define SWRITE_H(bf, cref_) do { SWRITE_HV(bf); SWRITE_HK(bf, cref_); } while (0)
template <bool FOX, int LDC>
__device__ __forceinline__ void attn_prime(const BlockRef& cur_, int W, char* lds, Seam& S) {
    BlockRef cur = cur_; cur.ld = LDC;
    const int tid_ = S.wave * 64 + pg8::lane_id_now();
    const int tid = tid_, wid = __builtin_amdgcn_readfirstlane(S.wave), lane = tid & 63, r32 = lane & 31, hi = lane >> 5;
    const int sr = tid >> 4, sc = (tid & 15) * 8, kws = KSWZ(sr, sc * 2); char* K_lds = lds + 2 * SHM_V; float* bias_l = (float*)(lds + OFF_BIAS);
    __builtin_amdgcn_s_waitcnt(0);
    const int kb0 = (FOX ? cur.jlo : swa_jlo(cur.P0, W)) * KVBLK;
    float cref = 0.f; if constexpr (FOX) cref = cur.cum[cur.P0];
    { const bf16* qw_ = cur.Q + (size_t)(wid * QBLK) * cur.ld; const int qo_ = r32 * cur.ld + hi * 8;
      for (int d0 = 0; d0 < 8; ++d0) S.qr[d0] = load8(qw_ + qo_ + d0 * 16); }
    SLOAD_H(cur, kb0); VMW(); SWRITE_HK(0, cref);
    __syncthreads();
}
template <bool FOX, bool SK, bool LSE, int LDC, int LDOC>
__device__ __forceinline__ void attn_block(const BlockRef& cur_, const BlockRef& nxt_, int W, char* lds, Seam& S) {
    BlockRef cur = cur_, nxt = nxt_; cur.ld = LDC; nxt.ld = LDC; cur.ldo = LDOC;
    const int tid_ = S.wave * 64 + pg8::lane_id_now();
    const int tid = tid_, wid = __builtin_amdgcn_readfirstlane(S.wave), lane = tid & 63, r32 = lane & 31, hi = lane >> 5;
    const int j_lo = FOX ? cur.jlo : swa_jlo(cur.P0, W);
    int j_hi = (cur.P0 + QB - 1) / KVBLK + 1; if (j_hi > cur.skv / KVBLK) j_hi = cur.skv / KVBLK;
    const int NT = j_hi - j_lo;
    const int kbn = (FOX ? nxt.jlo : swa_jlo(nxt.P0, W)) * KVBLK;
    const int qlo = cur.P0 + wid * QBLK, qm = qlo + r32 - 4 * hi;
    char* V_lds = lds; char* K_lds = lds + 2 * SHM_V;
    float* ws = (float*)(lds + OFF_WS) + wid * 64; float* li_l = ws, * al_l = ws + 32; float* bias_l = (float*)(lds + OFF_BIAS);
    float m_reg = -1e30f, l_reg = 0; f32x16 o[4] = {};
    const int sr = tid >> 4, sc = (tid & 15) * 8, vst0 = v_st(sr, sc), vst1 = v_st(32 + sr, sc), kws = KSWZ(sr, sc * 2);
    const int vb0 = (int)(uintptr_t)V_lds + v_rd_base(lane);
    float cref = 0.f, crefn = 0.f; if constexpr (FOX) { cref = cur.cum[cur.P0]; crefn = nxt.cum[nxt.P0]; }
#define RESC(a) do { if (__any((a) < 1.f)) { if (hi == 0) al_l[r32] = (a); asm volatile("s_waitcnt lgkmcnt(0)" ::: "memory");              \
                     for (int d_ = 0; d_ < 4; ++d_) for (int r = 0; r < 16; ++r) o[d_][r] *= al_l[crow(r, hi)]; } } while (0)
#define KBASE(t) ((j_lo + (t)) * KVBLK)
#define ACT(t) (KBASE(t) <= qlo + QBLK - 1 && KBASE(t) + KVBLK - 1 >= qlo - W + 1)
#define MASKT(P0_, P1_, t) do { const int kb_ = KBASE(t); if ((!SK || ACT(t)) && (kb_ + KVBLK - 1 > qlo || kb_ <= qlo + QBLK - 1 - W)) mask_tile(P0_, P1_, qm - kb_, (unsigned)W); } while (0)
    constexpr int NQL = 8;
#define SEAM_K0() do { VMWN(NQL); SWRITE_HK(0, crefn); SBAR(); } while (0)
    f32x16 pA0, pA1, pB0, pB1; float mnA, mnB, alA, alB; bf16x8 pa0, pa1, pa2, pa3;
    SWRITE_HV(0); SBAR();
    if (NT > 1) { SLOAD_H(cur, KBASE(1)); }
    SBAR(); qkt<0, SK, FOX>(pA0, pA1, K_lds, r32, hi, S.qr, ACT(0), bias_l);
    MASKT(pA0, pA1, 0); partialSM<FOX>(pA0, pA1, m_reg, mnA, alA);
    if (NT > 1) { VMW(); SWRITE_H(1, cref); }
    __syncthreads();
#define HALF_STEP(PX0, PX1, mnX, alX, PY0, PY1, alY, t, KB, VB, SB) do {                                                      \
        SBAR(); qkt<KB, SK, FOX>(PX0, PX1, K_lds, r32, hi, S.qr, ACT(t), bias_l);                                             \
        finishSM(PY0, PY1, alY, l_reg, pa0, pa1, pa2, pa3); SBAR();                                                           \
        if ((t) + 1 < NT) { SLOAD_H(cur, KBASE((t) + 1)); SBAR(); }                                                             \
        pv_tile<VB, SK>(o, vb0, pa0, pa1, pa2, pa3, ACT((t) - 1)); MASKT(PX0, PX1, (t)); partialSM<FOX>(PX0, PX1, m_reg, mnX, alX);   \
        __syncthreads();                                                                                                      \
        if ((t) + 1 < NT) { VMW(); SWRITE_H(SB, cref); }                                                                      \
        RESC(alX); __syncthreads(); } while (0)
    for (int t = 1; t + 1 < NT; t += 2) {
        HALF_STEP(pB0, pB1, mnB, alB, pA0, pA1, alA, t, 1, 0, 0);
        HALF_STEP(pA0, pA1, mnA, alA, pB0, pB1, alB, t + 1, 0, 1, 1);
    }
    const bool even = (NT & 1) == 0;
    if (even) { SBAR(); qkt<1, SK, FOX>(pB0, pB1, K_lds, r32, hi, S.qr, ACT(NT - 1), bias_l); SBAR(); }
    SLOAD_H(nxt, kbn); SBAR();
    { const bf16* qw_ = nxt.Q + (size_t)(wid * QBLK) * nxt.ld; const int qo_ = r32 * nxt.ld + hi * 8;
#pragma unroll
      for (int d0 = 0; d0 < 8; ++d0) S.qr[d0] = load8(qw_ + qo_ + d0 * 16); }
    SBAR();
    finishSM(pA0, pA1, alA, l_reg, pa0, pa1, pa2, pa3); SBAR();
    pv_tile<0, SK>(o, vb0, pa0, pa1, pa2, pa3, ACT(even ? NT - 2 : NT - 1));
    if (even) { MASKT(pB0, pB1, NT - 1); partialSM<FOX>(pB0, pB1, m_reg, mnB, alB); __syncthreads(); RESC(alB);
        finishSM(pB0, pB1, alB, l_reg, pa0, pa1, pa2, pa3); SBAR(); pv_tile<1, SK>(o, vb0, pa0, pa1, pa2, pa3, ACT(NT - 1)); }
    SBAR(); SEAM_K0();
    if (hi == 0) li_l[r32] = l_reg; asm volatile("s_waitcnt lgkmcnt(0)" ::: "memory");
    if constexpr (LSE) { int ro_ = wid * QBLK + r32; asm volatile("" : "+v"(ro_));
        if (hi == 0) cur.lse[ro_ * cur.lse_stride] = m_reg * SCALE + __logf(l_reg); }
    float rli[16];
#pragma unroll
    for (int r = 0; r < 16; ++r) rli[r] = __builtin_amdgcn_rcpf(li_l[crow(r, hi)]);
    bf16* Ow = cur.O + (size_t)(wid * QBLK) * cur.ldo;
#pragma unroll
    for (int r = 0; r < 16; ++r) { const int orow = crow(r, hi);
#pragma unroll
        for (int d0 = 0; d0 < 4; ++d0) { const float v = o[d0][r] * rli[r];
            const float vn = pg8::dpp_mov<0xB1>(v);
            if ((r32 & 1) == 0) *(unsigned*)(Ow + (orow * cur.ldo + d0 * 32 + r32)) = cvtpk(v, vn); } }
    __syncthreads();
#undef RESC
#undef KBASE
#undef ACT
#undef MASKT
#undef SEAM_K0
#undef HALF_STEP
}
#undef VMW
#undef VMWN
#undef SLOAD_H
#undef SWRITE_HK
#undef SWRITE_HV
#undef SWRITE_H
}


constexpr int NWAVES = 8;
#ifndef WGM_FFN_IN
#define WGM_FFN_IN 4
#endif
#ifndef WGM_FFN_OUT
#define WGM_FFN_OUT 4
#endif
#ifndef WGM_P4_QK
#define WGM_P4_QK 8
#endif
#ifndef WGM_OTHER
#define WGM_OTHER 4
#endif
constexpr size_t MiB = 1u << 20;
constexpr size_t WS_CTL = 0, CTL_ZERO_BYTES = 1 * MiB;
constexpr size_t WS_ROPE = 1 * MiB;
constexpr size_t WS_WF = 5 * MiB;
constexpr size_t WS_LOGF = 6 * MiB, WS_CUM = 7 * MiB;
constexpr size_t WS_LSE = 8 * MiB;
constexpr size_t WS_NRM = 9 * MiB + 512 * 1024;
constexpr int NRM_QN_WORDS = 32 * 32 * 4, NRM_KN_WORDS = 32 * 128 * 4;
constexpr size_t WS_P = 10 * MiB;
constexpr size_t WS_W = 74 * MiB, W_LAYER = 201 * MiB;
constexpr size_t WO_W1 = 0, WO_W2 = 44 * MiB, WO_W3 = 66 * MiB, WO_WA = 112 * MiB, WO_WB = 116 * MiB, WO_WO = 118 * MiB, WO_W6 = 126 * MiB, WO_W7 = 170 * MiB, WO_WP = 192 * MiB, WO_WG = 193 * MiB;
constexpr size_t WS_U = 878 * MiB;
constexpr size_t WS_BIG = 1006 * MiB;
constexpr size_t B_QA = 0, B_KA = 64 * MiB, B_VA = 128 * MiB;
constexpr size_t B_QB = 192 * MiB, B_KB = 288 * MiB, B_VB = 384 * MiB;
constexpr size_t B_GA = 480 * MiB, B_GB = 608 * MiB;
constexpr size_t B_H = 0;
constexpr size_t B_Y = 352 * MiB;
#ifndef XRES_BF16
#define XRES_BF16 1
#endif
constexpr bool XB = XRES_BF16 != 0;
constexpr size_t B_XF = 128 * MiB;
constexpr size_t B_T = 64 * MiB;
constexpr size_t WS_END = 1742 * MiB;
constexpr int CW_BAR = 4096;
constexpr int CW_QUEUE = 8192;

constexpr int RING_OFF = 0, RING_BYTES = 131072;
constexpr int LDSCTL_OFF = RING_BYTES, MISC_OFF = LDSCTL_OFF + 320;
constexpr int LDS_BYTES = 147456;

__device__ const double INVF[64] = {
1.0, 0.8659643233600653, 0.7498942093324559, 0.6493816315762113,
0.5623413251903491, 0.4869675251658631, 0.4216965034285822, 0.3651741272548377,
0.31622776601683794, 0.27384196342643613, 0.23713737056616552, 0.2053525026457146,
0.1778279410038923, 0.1539926526059492, 0.1333521432163324, 0.11547819846894582,
0.1, 0.08659643233600653, 0.07498942093324558, 0.06493816315762113,
0.05623413251903491, 0.04869675251658631, 0.042169650342858224, 0.03651741272548377,
0.03162277660168379, 0.027384196342643614, 0.023713737056616554, 0.02053525026457146,
0.01778279410038923, 0.01539926526059492, 0.01333521432163324, 0.011547819846894581,
0.01, 0.008659643233600654, 0.007498942093324558, 0.006493816315762113,
0.005623413251903491, 0.004869675251658631, 0.004216965034285823, 0.003651741272548377,
0.0031622776601683794, 0.0027384196342643613, 0.0023713737056616554, 0.002053525026457146,
0.0017782794100389228, 0.001539926526059492, 0.001333521432163324, 0.0011547819846894581,
0.001, 0.0008659643233600654, 0.0007498942093324559, 0.0006493816315762113,
0.0005623413251903491, 0.0004869675251658631, 0.00042169650342858224, 0.0003651741272548377,
0.00031622776601683794, 0.0002738419634264361, 0.00023713737056616554, 0.0002053525026457146,
0.00017782794100389227, 0.0001539926526059492, 0.0001333521432163324, 0.00011547819846894582};

struct Frame {
    LAS unsigned char* lds;
    volatile LAS unsigned* MISC;
    int tid, lane, wave, vcu, G;
    unsigned char* ws;
};
__device__ __forceinline__ float wave_sum(float v) { return pg8::xrow_sum(pg8::row16_sum(v)); }

__device__ __forceinline__ void tr_item(const float* W, int ldw, int c_src, int k0, bf16* dst, int K  , LAS float* scr, int lane) {
#pragma unroll
    for (int i = 0; i < 32; ++i) { const int kk = 2 * i + (lane >> 5); scr[kk * 33 + (lane & 31)] = __builtin_nontemporal_load(W + (size_t)(k0 + kk) * ldw + c_src + (lane & 31)); }
    LDS_WAIT(); asm volatile("" ::: "memory");
    const int c = lane & 7;
#pragma unroll
    for (int j = 0; j < 4; ++j) { const int n = (lane >> 3) + 8 * j; const LAS float* s = scr + (8 * c) * 33 + n;
        v4u o; o.x = pk2(s[0 * 33], s[1 * 33]); o.y = pk2(s[2 * 33], s[3 * 33]); o.z = pk2(s[4 * 33], s[5 * 33]); o.w = pk2(s[6 * 33], s[7 * 33]);
        __builtin_nontemporal_store(o, (v4u*)(dst + (size_t)n * K + k0 + 8 * c)); }
    LDS_WAIT(); asm volatile("" ::: "memory");
}
constexpr int I_W1 = (DM / 64) * (2 * DFF / 32), I_W2 = (DFF / 64) * (DM / 32), I_W3 = (DM / 64) * 368, I_WA = (1024 / 64) * (DM / 32), I_WB = (512 / 64) * (DM / 32),
              I_WO = (DM / 64) * (DM / 32), I_WP = (PLE / 64) * (DM / 32), I_LAYER = 2 * I_W1 + 2 * I_W2 + I_W3 + I_WA + I_WB + 2 * I_WO + I_WP;
struct In { const float *x, *p, *norm_g, *ffn1_in, *ffn1_out, *mix_in, *fox_b, *br_a, *br_b, *mix_out, *ffn2_in, *ffn2_out, *ple_proj, *ple_gate; };

__device__ __forceinline__ void tr_swiglu(const float* W, bf16* WT, int r, LAS float* scr, int lane) {
    const int nb = r % 352, kb = r / 352, c0 = 32 * nb, part = c0 >= DFF ? 1 : 0, cp = c0 - part * DFF;
    const int drow = 256 * (cp / 128) + 128 * part + (cp % 128);
    tr_item(W, 2 * DFF, c0, 64 * kb, WT + (size_t)drow * DM, DM, scr, lane);
}
__device__ __forceinline__ void tr_plain(const float* W, int K, int N, bf16* WT, int r, LAS float* scr, int lane, int pitch = 0, int koff = 0) {
    const int nblk = N / 32, nb = r % nblk, kb = r / nblk, P = pitch ? pitch : K;
    tr_item(W, N, 32 * nb, 64 * kb, WT + (size_t)(32 * nb) * P + koff, P, scr, lane);
}
__device__ __forceinline__ void tr_mix(const float* W, bf16* WT, int r, LAS float* scr, int lane) {
    const int nb = r % 368, kb = r / 368; int c_src, drow;
    if (nb < 96) { c_src = 32 * nb; drow = 32 * nb; }
    else if (nb < 240) { const int cc0 = 32 * (nb - 96); c_src = C_QB + cc0;
        if (cc0 < 3072) { const int t = cc0 / 1536, cq = cc0 % 1536, head = cq / 128, bj = (cq % 128) / 64, dd0 = cq % 64;
            drow = 3072 + 1536 * t + 256 * (head >> 1) + 128 * bj + 64 * (head & 1) + dd0; }
        else drow = 3072 + cc0; }
    else { const int cc0 = 32 * (nb - 240), part = cc0 >= 2048 ? 1 : 0, cp = cc0 - part * 2048; c_src = C_GA + cc0; drow = 7680 + 256 * (cp / 128) + 128 * part + (cp % 128); }
    tr_item(W, NCOLS, c_src, 64 * kb, WT + (size_t)drow * DM, DM, scr, lane);
}
__device__ __forceinline__ void sincos_d(double x, float& s, float& c) {
    const double q = __builtin_rint(x * 0.63661977236758134308);
    double r = __builtin_fma(-q, 1.5707963267948966192, x); r = __builtin_fma(-q, 6.123233995736766036e-17, r);
    const double r2 = r * r;
    double sp = -7.6471637318198164759e-13; sp = sp * r2 + 1.6059043836821614599e-10; sp = sp * r2 - 2.5052108385441718775e-08; sp = sp * r2 + 2.7557319223985890653e-06;
    sp = sp * r2 - 1.9841269841269841270e-04; sp = sp * r2 + 8.3333333333333333333e-03; sp = sp * r2 - 1.6666666666666666667e-01; const double sn = r + r * r2 * sp;
    double cp = 4.7794773323873852974e-14; cp = cp * r2 - 1.1470745597729724714e-11; cp = cp * r2 + 2.0876756987868098979e-09; cp = cp * r2 - 2.7557319223985890653e-07;
    cp = cp * r2 + 2.4801587301587301587e-05; cp = cp * r2 - 1.3888888888888888889e-03; cp = cp * r2 + 4.1666666666666666667e-02; cp = cp * r2 - 0.5; const double cs = 1.0 + r2 * cp;
    const int n = ((int)q) & 3;
    const double so = (n == 0) ? sn : (n == 1) ? cs : (n == 2) ? -sn : -cs;
    const double co = (n == 0) ? cs : (n == 1) ? -sn : (n == 2) ? -cs : sn;
    s = (float)so; c = (float)co;
}
__device__ __forceinline__ void p_prologue(Frame& F, const In& in) {
    LAS float* scr = (LAS float*)(F.lds + RING_OFF + F.wave * 16384);
    const int gw = F.vcu * NWAVES + F.wave, NGW = F.G * NWAVES;
    for (int it = gw; it < DEPTH * I_LAYER; it += NGW) {
        const int L = it / I_LAYER; int r = it - L * I_LAYER; unsigned char* wl = F.ws + WS_W + (size_t)L * W_LAYER;
        if (r < I_W1) { tr_swiglu(in.ffn1_in + (size_t)L * DM * 2 * DFF, (bf16*)(wl + WO_W1), r, scr, F.lane); continue; } r -= I_W1;
        if (r < I_W2) { tr_plain(in.ffn1_out + (size_t)L * DFF * DM, DFF, DM, (bf16*)(wl + WO_W2), r, scr, F.lane); continue; } r -= I_W2;
        if (r < I_W3) { tr_mix(in.mix_in + (size_t)L * DM * NCOLS, (bf16*)(wl + WO_W3), r, scr, F.lane); continue; } r -= I_W3;
        if (r < I_WA) { tr_plain(in.br_a + (size_t)L * 1024 * DM, 1024, DM, (bf16*)(wl + WO_WA), r, scr, F.lane, 1536, 0); continue; } r -= I_WA;
        if (r < I_WB) { tr_plain(in.br_b + (size_t)L * 512 * DM, 512, DM, (bf16*)(wl + WO_WA), r, scr, F.lane, 1536, 1024); continue; } r -= I_WB;
        if (r < I_WO) { tr_plain(in.mix_out + (size_t)L * DM * DM, DM, DM, (bf16*)(wl + WO_WO), r, scr, F.lane); continue; } r -= I_WO;
        if (r < I_W1) { tr_swiglu(in.ffn2_in + (size_t)L * DM * 2 * DFF, (bf16*)(wl + WO_W6), r, scr, F.lane); continue; } r -= I_W1;
        if (r < I_W2) { tr_plain(in.ffn2_out + (size_t)L * DFF * DM, DFF, DM, (bf16*)(wl + WO_W7), r, scr, F.lane); continue; } r -= I_W2;
        if (r < I_WP) { tr_plain(in.ple_proj + (size_t)L * PLE * DM, PLE, DM, (bf16*)(wl + WO_WP), r, scr, F.lane); continue; } r -= I_WP;
        tr_plain(in.ple_gate + (size_t)L * DM * DM, DM, DM, (bf16*)(wl + WO_WG), r, scr, F.lane);
    }
    const size_t gt = (size_t)blockIdx.x * 512 + F.tid, NT = (size_t)F.G * 512;
    { const f32x4* ps = (const f32x4*)in.p; v4u* pd = (v4u*)(F.ws + WS_P);
      for (size_t i = gt; i < (size_t)DEPTH * M * PLE / 8; i += NT) { const f32x4 a = __builtin_nontemporal_load(ps + 2 * i), b = __builtin_nontemporal_load(ps + 2 * i + 1);
          v4u o; o.x = pk2(a[0], a[1]); o.y = pk2(a[2], a[3]); o.z = pk2(b[0], b[1]); o.w = pk2(b[2], b[3]); pd[i] = o; } }
    { float* ct = (float*)(F.ws + WS_ROPE); float* st = ct + SEQ * 64;
      for (size_t i = gt; i < (size_t)SEQ * 64; i += NT) { const int t = (int)(i >> 6), dd = (int)(i & 63); float s, c; sincos_d((double)t * INVF[dd], s, c); ct[i] = c; st[i] = s; } }
    { float* wf = (float*)(F.ws + WS_WF);
      for (size_t i = gt; i < (size_t)DEPTH * 8 * DM; i += NT) { const int L = (int)(i / (8 * DM)), h = (int)((i / DM) & 7), k = (int)(i % DM);
          wf[i] = in.mix_in[((size_t)L * DM + k) * NCOLS + C_F + h]; } }
}

template <bool WITH_F, bool HAS_Y, bool HAS_U, bool Y_BF16, bool WRITE_X = true, bool XIN_BF16 = false, bool XOUT_BF16 = false>
__device__ __forceinline__ void norm_pass(Frame& F, const void* xin, const void* y, float coef, const float* gpost, const float* gpre, void* xout, bf16* U, const float* bfox, float* logf) {
    const int gw = F.vcu * NWAVES + F.wave, NGW = F.G * NWAVES;
    const LAS f32x4* wfl = (const LAS f32x4*)(F.lds + RING_OFF);
    LAS f32x4* gl = (LAS f32x4*)(F.lds + RING_OFF + 65536);
    { const int i_ = F.tid, pd = (2 * (i_ >> 7) + (i_ & 1)) * 64 + ((i_ & 127) >> 1);
      if (HAS_Y) gl[pd] = ((const f32x4*)gpost)[i_];
      if (HAS_U) gl[512 + pd] = ((const f32x4*)gpre)[i_]; }
    LDS_WAIT(); __syncthreads();
    typedef unsigned long long u64;
    f32x4 rxf[8]; v4u rxb[4]; f32x4 ryf[8]; v4u ryb[4];
#define NP_ISSUE(R) do { \
        if constexpr (XIN_BF16) { const v4u* xr_ = (const v4u*)((const bf16*)xin + (size_t)(R) * DM) + F.lane; \
            _Pragma("unroll") for (int j = 0; j < 4; ++j) rxb[j] = __builtin_nontemporal_load(xr_ + 64 * j); } \
        else { const f32x4* xr_ = (const f32x4*)((const float*)xin + (size_t)(R) * DM) + 2 * F.lane; \
            _Pragma("unroll") for (int j = 0; j < 8; ++j) rxf[j] = __builtin_nontemporal_load(xr_ + 128 * (j >> 1) + (j & 1)); } \
        if constexpr (HAS_Y) { \
            if constexpr (Y_BF16) { const v4u* yr_ = (const v4u*)((const bf16*)y + (size_t)(R) * DM) + F.lane; \
                _Pragma("unroll") for (int j = 0; j < 4; ++j) ryb[j] = __builtin_nontemporal_load(yr_ + 64 * j); } \
            else { const f32x4* yr_ = (const f32x4*)((const float*)y + (size_t)(R) * DM) + 2 * F.lane; \
                _Pragma("unroll") for (int j = 0; j < 8; ++j) ryf[j] = __builtin_nontemporal_load(yr_ + 128 * (j >> 1) + (j & 1)); } } } while (0)
    if (gw < M) NP_ISSUE(gw);
    for (int row = gw; row < M; row += NGW) {
        f32x4 xv[8];
#pragma unroll
        for (int j = 0; j < 8; ++j) {
            if constexpr (XIN_BF16) { const unsigned lo = (j & 1) ? rxb[j >> 1].z : rxb[j >> 1].x, hi = (j & 1) ? rxb[j >> 1].w : rxb[j >> 1].y;
                xv[j] = (f32x4){__uint_as_float(lo << 16), __uint_as_float(lo & 0xffff0000u), __uint_as_float(hi << 16), __uint_as_float(hi & 0xffff0000u)}; }
            else xv[j] = rxf[j]; }
        f32x4 yv[8];
        if constexpr (HAS_Y) {
#pragma unroll
            for (int j = 0; j < 8; ++j) {
                if constexpr (Y_BF16) { const unsigned lo = (j & 1) ? ryb[j >> 1].z : ryb[j >> 1].x, hi = (j & 1) ? ryb[j >> 1].w : ryb[j >> 1].y;
                    yv[j] = (f32x4){__uint_as_float(lo << 16), __uint_as_float(lo & 0xffff0000u), __uint_as_float(hi << 16), __uint_as_float(hi & 0xffff0000u)}; }
                else yv[j] = ryf[j]; } }
        { const int nrow = row + NGW; if (nrow < M) NP_ISSUE(nrow); }
        if (HAS_Y) {
            float ss = 0.f;
#pragma unroll
            for (int j = 0; j < 8; ++j) { ss += (yv[j][0] * yv[j][0] + yv[j][1] * yv[j][1]) + (yv[j][2] * yv[j][2] + yv[j][3] * yv[j][3]); }
            const float ry = coef / sqrtf(wave_sum(ss) * (1.f / DM) + RMS_EPS);
#pragma unroll
            for (int j = 0; j < 8; ++j) { const f32x4 g = gl[F.lane + 64 * j]; xv[j] += yv[j] * ry * g; }
        }
        if constexpr (WRITE_X) {
            if constexpr (XOUT_BF16) { v4u* xo = (v4u*)((bf16*)xout + (size_t)row * DM) + F.lane;
#pragma unroll
                for (int j = 0; j < 4; ++j) { v4u o; o.x = pk2(xv[2 * j][0], xv[2 * j][1]); o.y = pk2(xv[2 * j][2], xv[2 * j][3]); o.z = pk2(xv[2 * j + 1][0], xv[2 * j + 1][1]); o.w = pk2(xv[2 * j + 1][2], xv[2 * j + 1][3]);
                    __builtin_nontemporal_store(o, xo + 64 * j); } }
            else { f32x4* xo = (f32x4*)((float*)xout + (size_t)row * DM) + 2 * F.lane;
#pragma unroll
                for (int j = 0; j < 8; ++j) __builtin_nontemporal_store(xv[j], xo + 128 * (j >> 1) + (j & 1)); } }
        if (HAS_U) {
            float ss = 0.f;
#pragma unroll
            for (int j = 0; j < 8; ++j) ss += (xv[j][0] * xv[j][0] + xv[j][1] * xv[j][1]) + (xv[j][2] * xv[j][2] + xv[j][3] * xv[j][3]);
            const float rx = 1.f / sqrtf(wave_sum(ss) * (1.f / DM) + RMS_EPS);
            v4u* uo = (v4u*)(U + (size_t)row * DM) + F.lane;
#pragma unroll
            for (int j = 0; j < 8; ++j) { const f32x4 g = gl[512 + F.lane + 64 * j]; xv[j] = xv[j] * rx * g; }
#pragma unroll
            for (int j = 0; j < 4; ++j) { v4u o; o.x = pk2(xv[2 * j][0], xv[2 * j][1]); o.y = pk2(xv[2 * j][2], xv[2 * j][3]); o.z = pk2(xv[2 * j + 1][0], xv[2 * j + 1][1]); o.w = pk2(xv[2 * j + 1][2], xv[2 * j + 1][3]);
                uo[64 * j] = o; }
            if (WITH_F) {
                float mine = 0.f;
#pragma unroll 1
                for (int h = 0; h < 8; ++h) { float a = 0.f;
#pragma unroll
                    for (int j = 0; j < 8; ++j) { const f32x4 w = wfl[h * 512 + F.lane + 64 * j]; a += (xv[j][0] * w[0] + xv[j][1] * w[1]) + (xv[j][2] * w[2] + xv[j][3] * w[3]); }
                    a = wave_sum(a); mine = (F.lane == h) ? a : mine; }
                if (F.lane < 8) { const float v = mine + bfox[F.lane];
                    const float e = __builtin_amdgcn_exp2f(-1.4426950408889634f * fabsf(v));
                    const float l1p = (e < 0.03f) ? e * (1.f - e * (0.5f - e * (0.33333333f - e * 0.25f))) : 0.6931471805599453f * __builtin_amdgcn_logf(1.f + e);
                    const float ls = fminf(v, 0.f) - l1p;
                    const int b = row / SEQ, t = row - b * SEQ; logf[(size_t)(b * 8 + F.lane) * SEQ + t] = ls; }
            }
        }
    }
}
#undef NP_ISSUE
__device__ __forceinline__ void scan_phase(Frame& F, int bid) {
    LAS double* tot = (LAS double*)(F.lds + RING_OFF); LAS double* offp = tot + NWAVES * 64; LAS double* wsum = offp + NWAVES * 64;
    if (F.G == 256) {
        const int s = bid >> 3, j = bid & 7;
        const float* lf = (const float*)(F.ws + WS_LOGF) + (size_t)s * SEQ; float* cs = (float*)(F.ws + WS_CUM) + (size_t)s * SEQ;
        const float a0 = lf[1024 * j + 2 * F.tid], a1 = lf[1024 * j + 2 * F.tid + 1];
        double po = 0.0;
        { float tv[14];
#pragma unroll
          for (int k = 0; k < 14; ++k) tv[k] = (k < 2 * j) ? lf[F.tid + 512 * k] : 0.f;
#pragma unroll
          for (int k = 0; k < 14; ++k) po += (double)tv[k]; }
        tot[F.tid] = (double)a0 + (double)a1; offp[F.tid] = po;
        LDS_WAIT(); __syncthreads();
        double wt = 0.0, wo = 0.0, pre = 0.0;
        for (int i = 0; i < 64; ++i) { const double t = tot[F.wave * 64 + i], o = offp[F.wave * 64 + i]; wt += t; wo += o; pre += (i < F.lane) ? t : 0.0; }
        if (F.lane == 0) { wsum[F.wave] = wt; wsum[8 + F.wave] = wo; }
        LDS_WAIT(); __syncthreads();
        double base = pre;
        for (int w = 0; w < NWAVES; ++w) { base += wsum[8 + w]; base += (w < F.wave) ? wsum[w] : 0.0; }
        const double c0 = base + (double)a0, c1 = c0 + (double)a1;
        typedef float f32x2v __attribute__((ext_vector_type(2)));
        *(f32x2v*)(cs + 1024 * j + 2 * F.tid) = (f32x2v){(float)c0, (float)c1};
        __syncthreads();
        return;
    }
    if (bid >= 32) return;
    const float* lf = (const float*)(F.ws + WS_LOGF) + (size_t)bid * SEQ; float* cs = (float*)(F.ws + WS_CUM) + (size_t)bid * SEQ;
    f32x4 v[4]; double run = 0.0; double pre[16];
#pragma unroll
    for (int j = 0; j < 4; ++j) v[j] = ((const f32x4*)lf)[F.tid * 4 + j];
#pragma unroll
    for (int j = 0; j < 4; ++j)
#pragma unroll
        for (int e = 0; e < 4; ++e) { run += (double)v[j][e]; pre[4 * j + e] = run; }
    tot[F.tid] = run;
    LDS_WAIT(); __syncthreads();
    double base = 0.0;
    for (int i = 0; i < NWAVES * 64; ++i) { const double v = tot[i]; base += (i < F.tid) ? v : 0.0; }
#pragma unroll
    for (int j = 0; j < 4; ++j) { f32x4 o;
#pragma unroll
        for (int e = 0; e < 4; ++e) o[e] = (float)(base + pre[4 * j + e]);
        ((f32x4*)cs)[F.tid * 4 + j] = o; }
    __syncthreads();
}
__device__ __forceinline__ void combine_phase(Frame& F) {
    const int gw = F.vcu * NWAVES + F.wave, NGW = F.G * NWAVES;
    const float* lse = (const float*)(F.ws + WS_LSE); const bf16* og = (const bf16*)(F.ws + WS_BIG + B_QB); bf16* ob = (bf16*)(F.ws + WS_U);
    const int j = F.lane >> 4, d8 = (F.lane & 15) * 8;
    for (int tok0 = gw; tok0 < M; tok0 += 2 * NGW) {
        const int tok1 = (tok0 + NGW < M) ? tok0 + NGW : tok0;
        float l[2][3]; v4u raw[2][3];
#pragma unroll
        for (int q = 0; q < 2; ++q) { const int tok = q ? tok1 : tok0; const bf16* r = og + (size_t)tok * 1536 + j * 128 + d8;
#pragma unroll
            for (int g = 0; g < 3; ++g) { l[q][g] = lse[((size_t)g * M + tok) * 4 + j]; raw[q][g] = __builtin_nontemporal_load((const v4u*)(r + 512 * g)); } }
#pragma unroll
        for (int q = 0; q < 2; ++q) { const int tok = q ? tok1 : tok0;
            const float mx = fmaxf(l[q][0], fmaxf(l[q][1], l[q][2])); const float e0 = expf(l[q][0] - mx), e1 = expf(l[q][1] - mx), e2 = expf(l[q][2] - mx), inv = 1.f / (e0 + e1 + e2);
            f32x4 a0, a1, b0, b1, c0, c1; pg8::unpack8(raw[q][0], a0, a1); pg8::unpack8(raw[q][1], b0, b1); pg8::unpack8(raw[q][2], c0, c1);
            const float w0 = e0 * inv, w1 = e1 * inv, w2 = e2 * inv;
            *(v4u*)(ob + (size_t)tok * 1536 + 1024 + j * 128 + d8) = pg8::pack8(a0 * w0 + b0 * w1 + c0 * w2, a1 * w0 + b1 * w1 + c1 * w2); }
    }
}

__device__ __forceinline__ att::BlockRef fox_ref(unsigned char* ws, int n) {
    const int qb = 31 - (n >> 5), bh = n & 31, b = bh >> 3, h = bh & 7; const size_t base = (size_t)b * SEQ * 1024 + h * 128;
    att::BlockRef r; r.Q = (const bf16*)(ws + WS_BIG + B_QA) + base + (size_t)qb * 256 * 1024; r.K = (const bf16*)(ws + WS_BIG + B_KA) + base; r.V = (const bf16*)(ws + WS_BIG + B_VA) + base;
    r.O = (bf16*)(ws + WS_U) + ((size_t)b * SEQ + (size_t)qb * 256) * 1536 + h * 128; r.ldo = 1536;
    r.cum = (const float*)(ws + WS_CUM) + (size_t)bh * SEQ; r.lse = nullptr; r.P0 = qb * 256; r.ld = 1024; r.lse_stride = 0; r.skv = SEQ;
    const int l_ = pg8::lane_id_now();
    unsigned* qn = (unsigned*)(ws + WS_NRM) + (bh * 32 + qb) * 4; unsigned* kn = (unsigned*)(ws + WS_NRM) + NRM_QN_WORDS + bh * 128 * 4;
    float q2 = 0.f, ka = 0.f, kb = 0.f;
#pragma unroll
    for (int i = 0; i < 4; ++i) { q2 += __uint_as_float(__hip_atomic_load(qn + i, __ATOMIC_RELAXED, __HIP_MEMORY_SCOPE_AGENT));
        ka += __uint_as_float(__hip_atomic_load(kn + l_ * 4 + i, __ATOMIC_RELAXED, __HIP_MEMORY_SCOPE_AGENT)); kb += __uint_as_float(__hip_atomic_load(kn + (l_ + 64) * 4 + i, __ATOMIC_RELAXED, __HIP_MEMORY_SCOPE_AGENT)); }
    float kd = 0.f;
#pragma unroll
    for (int i = 0; i < 4; ++i) { const int d = 4 * qb + i; const float v = __uint_as_float((d < 64) ? __builtin_amdgcn_readlane(__float_as_uint(ka), d & 63) : __builtin_amdgcn_readlane(__float_as_uint(kb), d & 63)); kd = fmaxf(kd, v); }
    const float SC = ATT_SCALE * 1.01f, Ts = sqrtf(q2 * kd) * SC + 26.f, Ta = Ts + sqrtf(q2 * ka) * SC, Tb = Ts + sqrtf(q2 * kb) * SC;
    const float c0 = r.cum[r.P0];
    int k0 = 64 * l_ + 63, k1 = k0 + 4096; if (k0 > r.P0) k0 = r.P0; if (k1 > r.P0) k1 = r.P0;
    const unsigned long long m0 = __ballot((r.cum[k0] - c0) < Ta), m1 = __ballot((r.cum[k1] - c0) < Tb);
    r.jlo = m0 ? __builtin_ctzll(m0) : (m1 ? 64 + __builtin_ctzll(m1) : 0);
    return r;
}
template <int G_IDX>
__device__ __forceinline__ att::BlockRef dil_ref(unsigned char* ws, int r_) {
    constexpr int g = G_IDX, d = (g == 0) ? 1 : (g == 1) ? 4 : 16, nqb = 32 / d, ld = d * 1536;
    const int seq = r_ / nqb, qb = r_ % nqb, b = seq / (4 * d), j = (seq / d) & 3, res = seq % d, head = 4 * g + j;
    const size_t off = ((size_t)b * SEQ + res) * 1536 + head * 128;
    att::BlockRef r; r.Q = (const bf16*)(ws + WS_BIG + B_QB) + off + (size_t)qb * 256 * ld; r.K = (const bf16*)(ws + WS_BIG + B_KB) + off; r.V = (const bf16*)(ws + WS_BIG + B_VB) + off;
    r.O = const_cast<bf16*>(r.Q); r.cum = nullptr; r.lse = (float*)(ws + WS_LSE) + ((size_t)g * M + (size_t)b * SEQ + res + (size_t)qb * 256 * d) * 4 + j; r.P0 = qb * 256; r.ld = ld; r.ldo = ld; r.lse_stride = d * 4; r.skv = SEQ / d; return r;
}
template <int G_IDX>
__device__ __forceinline__ void dil_stream(Frame& F, char* ldsg, unsigned* qhead, att::Seam& S) {
    constexpr int d = (G_IDX == 0) ? 1 : (G_IDX == 1) ? 4 : 16, LD = d * 1536; const int W = 129;
    volatile LAS int* slot = (volatile LAS int*)(F.lds + RING_OFF + att::OFF_QSLOT);
    const int tid_ = F.wave * 64 + pg8::lane_id_now();
    if (tid_ == 0) { slot[0] = (int)__hip_atomic_fetch_add(qhead, 1u, __ATOMIC_RELAXED, __HIP_MEMORY_SCOPE_AGENT); slot[1] = (int)__hip_atomic_fetch_add(qhead, 1u, __ATOMIC_RELAXED, __HIP_MEMORY_SCOPE_AGENT); }
    __syncthreads();
    int n_cur = __builtin_amdgcn_readfirstlane(slot[0]), n_nxt = __builtin_amdgcn_readfirstlane(slot[1]);
    __syncthreads();
    if (n_cur >= 512) return;
    att::BlockRef cur = dil_ref<G_IDX>(F.ws, n_cur);
    att::attn_prime<false, LD>(cur, W, ldsg, S);
    for (;;) { const bool last = n_nxt >= 512; const att::BlockRef nxt = last ? cur : dil_ref<G_IDX>(F.ws, n_nxt);
        att::attn_block<false, true, true, LD, LD>(cur, nxt, W, ldsg, S);
        if (last) break;
        if (tid_ == 0) slot[0] = (int)__hip_atomic_fetch_add(qhead, 1u, __ATOMIC_RELAXED, __HIP_MEMORY_SCOPE_AGENT);
        __syncthreads();
        const int nn = __builtin_amdgcn_readfirstlane(slot[0]);
        cur = nxt; n_cur = n_nxt; n_nxt = nn; }
}
__device__ __forceinline__ void attn_phase(Frame& F, char* ldsg, int bid, int G, int layer) {
    att::Seam S; S.wave = F.wave;
    {
        unsigned* qhead = (unsigned*)(F.ws + WS_CTL) + CW_QUEUE + 64 * layer; volatile LAS int* slot = (volatile LAS int*)(F.lds + RING_OFF + att::OFF_QSLOT);
        const int W = 1 << 30; const int tid_ = F.wave * 64 + pg8::lane_id_now();
        if (tid_ == 0) { slot[0] = (int)__hip_atomic_fetch_add(qhead, 1u, __ATOMIC_RELAXED, __HIP_MEMORY_SCOPE_AGENT); slot[1] = (int)__hip_atomic_fetch_add(qhead, 1u, __ATOMIC_RELAXED, __HIP_MEMORY_SCOPE_AGENT); }
        __syncthreads();
        int n_cur = __builtin_amdgcn_readfirstlane(slot[0]), n_nxt = __builtin_amdgcn_readfirstlane(slot[1]);
        __syncthreads();
        if (n_cur < 1024) {
            att::BlockRef cur = fox_ref(F.ws, n_cur);
            att::attn_prime<true, 1024>(cur, W, ldsg, S);
            for (;;) { const bool last = n_nxt >= 1024;
                const att::BlockRef nxt = last ? cur : fox_ref(F.ws, n_nxt);
                int g_ = 0; if (!last && tid_ == 0) g_ = (int)__hip_atomic_fetch_add(qhead, 1u, __ATOMIC_RELAXED, __HIP_MEMORY_SCOPE_AGENT);
                att::attn_block<true, false, false, 1024, 1536>(cur, nxt, W, ldsg, S);
                if (last) break;
                if (tid_ == 0) slot[0] = g_;
                __syncthreads();
                const int nn = __builtin_amdgcn_readfirstlane(slot[0]);
                cur = nxt; n_cur = n_nxt; n_nxt = nn; }
        }
    }
    { unsigned* qd = (unsigned*)(F.ws + WS_CTL) + CW_QUEUE + 64 * (4 + 3 * layer); (void)bid; (void)G;
      dil_stream<0>(F, ldsg, qd, S); dil_stream<1>(F, ldsg, qd + 64, S); dil_stream<2>(F, ldsg, qd + 128, S); }
}

#if MK_NAIVE_ATTN
__global__ __launch_bounds__(256) void naive_attn(unsigned char* ws, int mode) {
    __shared__ __attribute__((aligned(16))) bf16 Kt[64 * 128];
    __shared__ __attribute__((aligned(16))) bf16 Vt[64 * 128];
    __shared__ float biasl[64];
    const int tid = threadIdx.x, qi = tid >> 2, part = tid & 3;
    const bf16 *Q, *K, *V; float* lse = nullptr; const float* cum = nullptr; int pitch, W, P0, lstride = 0;
    if (mode == 0) { const int it = blockIdx.x, qb = 127 - it / 32, s = it % 32, b = s >> 3, h = s & 7; const size_t off = (size_t)b * SEQ * 1024 + h * 128;
        Q = (const bf16*)(ws + WS_BIG + B_QA) + off; K = (const bf16*)(ws + WS_BIG + B_KA) + off; V = (const bf16*)(ws + WS_BIG + B_VA) + off; pitch = 1024; W = 1 << 30; P0 = qb * 64;
        cum = (const float*)(ws + WS_CUM) + (size_t)s * SEQ; }
    else { const int it = blockIdx.x, g = it / 2048, r = it % 2048, d = (g == 0) ? 1 : (g == 1) ? 4 : 16, L = SEQ / d, nqb = L / 64, seq = r / nqb, qb = r % nqb;
        const int b = seq / (4 * d), j = (seq / d) & 3, res = seq % d, head = 4 * g + j; const size_t off = ((size_t)b * SEQ + res) * 1536 + head * 128;
        Q = (const bf16*)(ws + WS_BIG + B_QB) + off; K = (const bf16*)(ws + WS_BIG + B_KB) + off; V = (const bf16*)(ws + WS_BIG + B_VB) + off; pitch = d * 1536; W = 129; P0 = qb * 64;
        lse = (float*)(ws + WS_LSE) + ((size_t)g * M + (size_t)b * SEQ + res) * 4 + j; lstride = d * 4; }
    const int i = P0 + qi;
    float q[32], o[32];
    { const v4u* qp = (const v4u*)(Q + (size_t)i * pitch + 32 * part);
#pragma unroll
      for (int c = 0; c < 4; ++c) { f32x4 a, b; pg8::unpack8(qp[c], a, b);
#pragma unroll
          for (int e = 0; e < 4; ++e) { q[8 * c + e] = a[e]; q[8 * c + 4 + e] = b[e]; } } }
#pragma unroll
    for (int e = 0; e < 32; ++e) o[e] = 0.f;
    const float ci = cum ? cum[i] : 0.f;
    float m = -1e30f, l = 0.f;
    int jstart = P0 - (W - 1); if (jstart < 0 || W > SEQ) jstart = 0; jstart &= ~63;
    for (int j0 = jstart; j0 < P0 + 64; j0 += 64) {
        __syncthreads();
#pragma unroll
        for (int c = 0; c < 4; ++c) { const int idx = tid + 256 * c, row = idx >> 4, ch = idx & 15;
            *(v4u*)(Kt + row * 128 + ch * 8) = *(const v4u*)(K + (size_t)(j0 + row) * pitch + ch * 8);
            *(v4u*)(Vt + row * 128 + ch * 8) = *(const v4u*)(V + (size_t)(j0 + row) * pitch + ch * 8); }
        if (cum && tid < 64) biasl[tid] = cum[j0 + tid];
        __syncthreads();
        for (int kk0 = 0; kk0 < 64; kk0 += 8) {
            float s[8]; float cmax = -__builtin_inff();
#pragma unroll
            for (int e = 0; e < 8; ++e) { const int kk = kk0 + e; const v4u* kp = (const v4u*)(Kt + kk * 128 + 32 * part); float dot = 0.f;
#pragma unroll
                for (int c = 0; c < 4; ++c) { f32x4 a, b; pg8::unpack8(kp[c], a, b);
#pragma unroll
                    for (int x = 0; x < 4; ++x) dot += q[8 * c + x] * a[x] + q[8 * c + 4 + x] * b[x]; }
                dot += __shfl_xor(dot, 1); dot += __shfl_xor(dot, 2);
                const int jj = j0 + kk; const bool valid = (jj <= i) && (i - jj < W);
                float sc = dot * ATT_SCALE; if (cum) sc += ci - biasl[kk];
                s[e] = valid ? sc : -__builtin_inff(); cmax = fmaxf(cmax, s[e]); }
            const float mn = fmaxf(m, cmax), alpha = expf(m - mn); m = mn; l *= alpha;
#pragma unroll
            for (int e = 0; e < 32; ++e) o[e] *= alpha;
#pragma unroll
            for (int e = 0; e < 8; ++e) { const float p = expf(s[e] - mn); l += p; const v4u* vp = (const v4u*)(Vt + (kk0 + e) * 128 + 32 * part);
#pragma unroll
                for (int c = 0; c < 4; ++c) { f32x4 a, b; pg8::unpack8(vp[c], a, b);
#pragma unroll
                    for (int x = 0; x < 4; ++x) { o[8 * c + x] += p * a[x]; o[8 * c + 4 + x] += p * b[x]; } } }
        }
    }
    const float inv = 1.f / l;
    { v4u* op = (v4u*)(const_cast<bf16*>(Q) + (size_t)i * pitch + 32 * part);
#pragma unroll
      for (int c = 0; c < 4; ++c) op[c] = pg8::pack8((f32x4){o[8 * c] * inv, o[8 * c + 1] * inv, o[8 * c + 2] * inv, o[8 * c + 3] * inv}, (f32x4){o[8 * c + 4] * inv, o[8 * c + 5] * inv, o[8 * c + 6] * inv, o[8 * c + 7] * inv}); }
    if (lse && part == 0) lse[(size_t)i * lstride] = m + logf(l);
}

#endif
constexpr int NPH_LAYER = 14, PH_TOTAL = 2 + DEPTH * NPH_LAYER;
struct Args { const float* in[14]; float* out; unsigned char* ws; int lo, hi; };
__global__ void __launch_bounds__(NWAVES * 64, 2) fwd(Args args) {
    extern __shared__ __attribute__((aligned(16))) unsigned char lds[];
    Frame F;
    F.lds = (LAS unsigned char*)lds; F.MISC = (volatile LAS unsigned*)(F.lds + MISC_OFF);
    F.tid = threadIdx.x; F.lane = F.tid & 63; F.wave = __builtin_amdgcn_readfirstlane(F.tid >> 6);
    F.G = gridDim.x; { const int bx = blockIdx.x; F.vcu = (F.G % 8 == 0) ? (bx % 8) * (F.G / 8) + bx / 8 : bx; }
    F.ws = args.ws;
    In in; in.x = args.in[0]; in.p = args.in[1]; in.norm_g = args.in[2]; in.ffn1_in = args.in[3]; in.ffn1_out = args.in[4]; in.mix_in = args.in[5]; in.fox_b = args.in[6]; in.br_a = args.in[7];
    in.br_b = args.in[8]; in.mix_out = args.in[9]; in.ffn2_in = args.in[10]; in.ffn2_out = args.in[11]; in.ple_proj = args.in[12]; in.ple_gate = args.in[13];
    for (int u = F.tid; u < (LDS_BYTES - LDSCTL_OFF) / 4; u += NWAVES * 64) ((LAS unsigned*)(F.lds + LDSCTL_OFF))[u] = 0u;
    __syncthreads();
    XcdBarrier bar = xcd_barrier_post((unsigned*)(F.ws + WS_CTL) + CW_BAR, F.MISC + 8); bar.wave = F.wave;
#define IN(k) (lo <= (k) && (k) < hi)
#ifndef PH_MASK
#define PH_MASK 0xffff
#endif
#define PHM(k) (((PH_MASK) >> (k)) & 1)
#define REFRESH_TID() do { const int l_ = pg8::lane_id_now(); F.lane = l_; F.tid = F.wave * 64 + l_; } while (0)
#define SEAM(k) do { if (IN(k) && IN((k) + 1)) xcd_barrier(bar); } while (0)
    LAS unsigned char* const ring = F.lds + RING_OFF;

    { const int lo = args.lo, hi = args.hi; if (PHM(14) && IN(0)) { p_prologue(F, in); SEAM(0); } }

    for (int L = 0; L < DEPTH; ++L) {
        size_t z_ = 0; int lo = args.lo, hi = args.hi;
        asm volatile("" : "+s"(z_), "+s"(lo), "+s"(hi));
        unsigned char* ws_ = args.ws + z_; float* out_ = args.out + z_; const float* ng_ = args.in[2] + z_; const float* fb_ = args.in[6] + z_;
        F.ws = ws_; in.norm_g = ng_; in.fox_b = fb_;
        unsigned char* const big = F.ws + WS_BIG; bf16* const U = (bf16*)(F.ws + WS_U); float* const Y = (float*)(big + B_Y); void* const xres = (void*)out_;
        REFRESH_TID();
        int bid_ = blockIdx.x, G_ = gridDim.x; asm volatile("" : "+s"(bid_), "+s"(G_));
        F.G = G_; F.vcu = (G_ % 8 == 0) ? (bid_ % 8) * (G_ / 8) + bid_ / 8 : bid_;
        const int pb = 1 + NPH_LAYER * L; unsigned char* const wl = F.ws + WS_W + (size_t)L * W_LAYER; const float* const g = in.norm_g + (size_t)L * 8 * DM;
        if (PHM(0) && IN(pb + 0)) { REFRESH_TID();
            if (L == 0) norm_pass<false, false, true, false, XB, false, XB>(F, in.x, nullptr, 0.f, nullptr, g + 0 * DM, xres, U, nullptr, nullptr);
            else norm_pass<false, true, true, true, true, XB, XB>(F, xres, Y, 1.f, g - 8 * DM + 7 * DM, g + 0 * DM, xres, U, nullptr, nullptr);
            SEAM(pb + 0); }
        if (PHM(1) && IN(pb + 1)) { pg8::Gemm gm{U, (const bf16*)(wl + WO_W1), M, 2 * DFF, DM}; gm.wave = F.wave; pg8::StaticOrder S; S.init(M, 2 * DFF, F.G, bid_, WGM_FFN_IN);
            pg8::EpiSwiGLU E{(bf16*)(big + B_H), DFF}; pg8::gemm_phase<pg8::EpiSwiGLU, pg8::StaticOrder, true, true>(ring, gm, S, E); SEAM(pb + 1); }
        if (PHM(2) && IN(pb + 2)) { pg8::Gemm gm{(const bf16*)(big + B_H), (const bf16*)(wl + WO_W2), M, DM, DFF}; gm.wave = F.wave; gm.a_tiled = 1; pg8::StaticOrder S; S.init(M, DM, F.G, bid_, WGM_FFN_OUT);
            pg8::EpiSplitBf16<0> E{(bf16*)Y, DM, 0, 0}; pg8::gemm_phase<pg8::EpiSplitBf16<0>, pg8::StaticOrder, true, true>(ring, gm, S, E); SEAM(pb + 2); }
        if (PHM(3) && IN(pb + 3)) { REFRESH_TID();
            { const f32x4* wf4 = (const f32x4*)((const float*)(F.ws + WS_WF) + (size_t)L * 8 * DM); LAS f32x4* wl4 = (LAS f32x4*)ring;
              f32x4 t_[8];
#pragma unroll
              for (int j = 0; j < 8; ++j) t_[j] = wf4[F.tid + 512 * j];
#pragma unroll
              for (int j = 0; j < 8; ++j) { const int f4 = F.tid;
                  wl4[j * 512 + (2 * (f4 >> 7) + (f4 & 1)) * 64 + ((f4 & 127) >> 1)] = t_[j]; }
              LDS_WAIT(); __syncthreads(); }
            for (int i = bid_ * (NWAVES * 64) + F.tid; i < NRM_QN_WORDS + NRM_KN_WORDS; i += F.G * (NWAVES * 64)) ((unsigned*)(F.ws + WS_NRM))[i] = 0u;
            norm_pass<true, true, true, true, true, XB, XB>(F, (!XB && L == 0) ? (const void*)in.x : (const void*)xres, Y, 0.5f, g + 1 * DM, g + 2 * DM, xres, U, in.fox_b + L * 8, (float*)(F.ws + WS_LOGF));
            SEAM(pb + 3); }
        if (PHM(4) && IN(pb + 4)) {
#ifndef P4MASK
#define P4MASK 31
#endif
            if (P4MASK & 16) { REFRESH_TID(); scan_phase(F, bid_); }
            const bf16* W3 = (const bf16*)(wl + WO_W3);
            if (P4MASK & 1) { pg8::Gemm gm{U, W3, M, 3072, DM}; gm.wave = F.wave; pg8::StaticOrder S; S.init(M, 3072, F.G, bid_, WGM_P4_QK);
              pg8::EpiFoxQKV E{(bf16*)(big + B_QA), (unsigned*)(F.ws + WS_NRM), (unsigned*)(F.ws + WS_NRM) + NRM_QN_WORDS}; pg8::gemm_phase<pg8::EpiFoxQKV, pg8::StaticOrder, true, true>(ring, gm, S, E); }
            if (P4MASK & 2) { pg8::Gemm gm{U, W3 + (size_t)3072 * DM, M, 3072, DM}; gm.wave = F.wave; pg8::StaticOrder S; S.init(M, 3072, F.G, bid_, WGM_P4_QK);
              pg8::EpiRope E{(bf16*)(big + B_QB), (bf16*)(big + B_KB), (const float*)(F.ws + WS_ROPE), (const float*)(F.ws + WS_ROPE) + SEQ * 64}; pg8::gemm_phase<pg8::EpiRope, pg8::StaticOrder, true, true>(ring, gm, S, E); }
            if (P4MASK & 4) { pg8::Gemm gm{U, W3 + (size_t)6144 * DM, M, 1536, DM}; gm.wave = F.wave; pg8::StaticOrder S; S.init(M, 1536, F.G, bid_, WGM_P4_QK);
              pg8::EpiSplitBf16<0> E{(bf16*)(big + B_VB), 1536, 0, 0}; pg8::gemm_phase<pg8::EpiSplitBf16<0>, pg8::StaticOrder, true, true>(ring, gm, S, E); }
            if (P4MASK & 8) { pg8::Gemm gm{U, W3 + (size_t)7680 * DM, M, 4096, DM}; gm.wave = F.wave; pg8::StaticOrder S; S.init(M, 4096, F.G, bid_, WGM_OTHER);
              pg8::EpiGates E{(bf16*)(big + B_GA), (bf16*)(big + B_GB)}; pg8::gemm_phase<pg8::EpiGates, pg8::StaticOrder, true, true>(ring, gm, S, E); }
            SEAM(pb + 4); }
#if !MK_NAIVE_ATTN
        if (PHM(5) && IN(pb + 5)) { attn_phase(F, (char*)lds, bid_, G_, L); SEAM(pb + 5); }
#else
        if (PHM(5) && IN(pb + 5)) { SEAM(pb + 5); }
#endif
        if (PHM(6) && IN(pb + 6)) { REFRESH_TID(); combine_phase(F); SEAM(pb + 6); }
        if (PHM(7) && IN(pb + 7)) {
            { pg8::Gemm gm{(const bf16*)(F.ws + WS_U), (const bf16*)(wl + WO_WA), M, DM, 1536}; gm.wave = F.wave; pg8::StaticOrder S; S.init(M, DM, F.G, bid_, WGM_OTHER);
              pg8::EpiMixOut E{(const bf16*)(big + B_GA), (const bf16*)(big + B_GB), (bf16*)(big + B_T)}; pg8::gemm_phase<pg8::EpiMixOut, pg8::StaticOrder, true, true>(ring, gm, S, E); }
            SEAM(pb + 7); }
        if (PHM(8) && IN(pb + 8)) { pg8::Gemm gm{(const bf16*)(big + B_T), (const bf16*)(wl + WO_WO), M, DM, DM}; gm.wave = F.wave; pg8::StaticOrder S; S.init(M, DM, F.G, bid_, WGM_OTHER);
            pg8::EpiSplitBf16<0> E{(bf16*)Y, DM, 0, 0}; pg8::gemm_phase<pg8::EpiSplitBf16<0>, pg8::StaticOrder, true, true>(ring, gm, S, E); SEAM(pb + 8); }
        if (PHM(9) && IN(pb + 9)) { REFRESH_TID(); norm_pass<false, true, true, true, true, XB, XB>(F, xres, Y, 1.f, g + 3 * DM, g + 4 * DM, xres, U, nullptr, nullptr); SEAM(pb + 9); }
        if (PHM(10) && IN(pb + 10)) { pg8::Gemm gm{U, (const bf16*)(wl + WO_W6), M, 2 * DFF, DM}; gm.wave = F.wave; pg8::StaticOrder S; S.init(M, 2 * DFF, F.G, bid_, WGM_FFN_IN);
            pg8::EpiSwiGLU E{(bf16*)(big + B_H), DFF}; pg8::gemm_phase<pg8::EpiSwiGLU, pg8::StaticOrder, true, true>(ring, gm, S, E); SEAM(pb + 10); }
        if (PHM(11) && IN(pb + 11)) { pg8::Gemm gm{(const bf16*)(big + B_H), (const bf16*)(wl + WO_W7), M, DM, DFF}; gm.wave = F.wave; gm.a_tiled = 1; pg8::StaticOrder S; S.init(M, DM, F.G, bid_, WGM_FFN_OUT);
            pg8::EpiSplitBf16<0> E{(bf16*)Y, DM, 0, 0}; pg8::gemm_phase<pg8::EpiSplitBf16<0>, pg8::StaticOrder, true, true>(ring, gm, S, E); SEAM(pb + 11); }
        if (PHM(12) && IN(pb + 12)) { REFRESH_TID(); norm_pass<false, true, true, true, true, XB, XB>(F, xres, Y, 0.5f, g + 5 * DM, g + 6 * DM, (XB && L == DEPTH - 1) ? (void*)(big + B_XF) : xres, U, nullptr, nullptr); SEAM(pb + 12); }
        if (PHM(13) && IN(pb + 13)) {
            { pg8::Gemm gm{(const bf16*)(F.ws + WS_P) + (size_t)L * M * PLE, (const bf16*)(wl + WO_WP), M, DM, PLE}; gm.wave = F.wave; pg8::StaticOrder S; S.init(M, DM, F.G, bid_, WGM_OTHER);
              pg8::EpiSplitBf16<0> E{(bf16*)(big + B_H), DM, 0, 0}; pg8::gemm_phase<pg8::EpiSplitBf16<0>, pg8::StaticOrder, true, true>(ring, gm, S, E); }
            { pg8::Gemm gm{U, (const bf16*)(wl + WO_WG), M, DM, DM}; gm.wave = F.wave; pg8::StaticOrder S; S.init(M, DM, F.G, bid_, WGM_OTHER);
              pg8::EpiPle E{(const bf16*)(big + B_H), (bf16*)Y}; pg8::gemm_phase<pg8::EpiPle, pg8::StaticOrder, true, true>(ring, gm, S, E); }
            SEAM(pb + 13); }
    }
    { size_t z_ = 0; int lo = args.lo, hi = args.hi; asm volatile("" : "+s"(z_), "+s"(lo), "+s"(hi)); REFRESH_TID();
      { int bid_ = blockIdx.x, G_ = gridDim.x; asm volatile("" : "+s"(bid_), "+s"(G_)); F.G = G_; F.vcu = (G_ % 8 == 0) ? (bid_ % 8) * (G_ / 8) + bid_ / 8 : bid_; }
      float* const xres = args.out + z_; float* const Y = (float*)(args.ws + z_ + WS_BIG + B_Y); const bf16* const xfin = (const bf16*)(args.ws + z_ + WS_BIG + B_XF); F.ws = args.ws + z_; in.norm_g = args.in[2] + z_;
    if (PHM(15) && IN(PH_TOTAL - 1)) norm_pass<false, true, false, true, true, XB, false>(F, XB ? (const void*)xfin : (const void*)xres, Y, 1.f, in.norm_g + (size_t)(DEPTH - 1) * 8 * DM + 7 * DM, nullptr, xres, nullptr, nullptr, nullptr); }
#undef IN
#undef SEAM
}

#ifdef DUMP_OFF
__global__ void dump_fold(const unsigned short* src, size_t n, float* out, size_t nout) {
    for (size_t i = (size_t)blockIdx.x * blockDim.x + threadIdx.x; i < nout; i += (size_t)gridDim.x * blockDim.x) {
        float s = 0.f; for (size_t k = i; k < n; k += nout) { const unsigned short v = src[k]; const unsigned short e = (v >> 7) & 0xff; const float f = (e == 0xff) ? 12345.f : __uint_as_float(((unsigned)v) << 16); s += f; }
        out[i] = s; }
}
#endif
extern "C" void kernel_launch(void* const* d_in, const int* in_sizes, int n_in, void* d_out, int out_size, void* d_ws, size_t ws_size, hipStream_t stream) {
    static int grid = 0;
    if (grid == 0) {
        if (n_in != 14 || in_sizes[0] != M * DM || out_size != M * DM || ws_size < WS_END) { fprintf(stderr, "kernel_launch: unexpected shapes / workspace (n_in %d, ws %zu < %zu); nothing launched\n", n_in, ws_size, (size_t)WS_END); grid = -1; return; }
        int dev = 0, cus = 0;
        if (hipGetDevice(&dev) != hipSuccess || hipDeviceGetAttribute(&cus, hipDeviceAttributeMultiprocessorCount, dev) != hipSuccess) { grid = -1; return; }
        if (hipFuncSetAttribute((const void*)fwd, hipFuncAttributeMaxDynamicSharedMemorySize, LDS_BYTES) != hipSuccess) { fprintf(stderr, "kernel_launch: hipFuncSetAttribute failed\n"); grid = -1; return; }
        int per_cu = 0; (void)hipOccupancyMaxActiveBlocksPerMultiprocessor(&per_cu, (const void*)fwd, NWAVES * 64, LDS_BYTES); (void)hipGetLastError();
        grid = cus;
    }
    if (grid < 0) return;
    (void)hipMemsetAsync((char*)d_ws + WS_CTL, 0, CTL_ZERO_BYTES, stream);
    Args a{};
    for (int i = 0; i < 14; ++i) a.in[i] = (const float*)d_in[i];
    a.out = (float*)d_out; a.ws = (unsigned char*)d_ws;
#if MK_BRINGUP
#ifndef STOP_AT
#define STOP_AT PH_TOTAL
#endif
    for (int ph = 0; ph < STOP_AT; ++ph) {
        const int p = (ph >= 1 && ph < PH_TOTAL - 1) ? (ph - 1) % NPH_LAYER : -1;
#if MK_NAIVE_ATTN
        if (p == 5) { hipLaunchKernelGGL(naive_attn, dim3(4096), dim3(256), 0, stream, (unsigned char*)d_ws, 0); hipLaunchKernelGGL(naive_attn, dim3(6144), dim3(256), 0, stream, (unsigned char*)d_ws, 1); continue; }
#endif
        (void)p;
        a.lo = ph; a.hi = ph + 1;
        hipLaunchKernelGGL(fwd, dim3(grid), dim3(NWAVES * 64), LDS_BYTES, stream, a);
    }
#ifdef DUMP_OFF
    hipLaunchKernelGGL(dump_fold, dim3(2048), dim3(256), 0, stream, (const unsigned short*)((unsigned char*)d_ws + (size_t)(DUMP_OFF)), (size_t)(DUMP_N), (float*)d_out, (size_t)M * DM);
#endif
#else
    a.lo = 0; a.hi = PH_TOTAL;
    hipLaunchKernelGGL(fwd, dim3(grid), dim3(NWAVES * 64), LDS_BYTES, stream, a);
#endif
}
```

```cpp
#include <hip/hip_runtime.h>
#include <cstdio>
#include <cstdint>

constexpr int DM = 2048, NBATCH = 4, SEQ = 8192, DEPTH = 4, HD = 128, FOXH = 8, DILH = 12, DFF = 5632, PLE = 256;
constexpr int M = NBATCH * SEQ;
constexpr int NCOLS = 11784;
constexpr int C_F = 3072, C_QB = 3080, C_GA = 7688;
constexpr float RMS_EPS = 1e-6f;
constexpr float ATT_SCALE = 0.08838834764831845f;

#ifndef MK_BRINGUP
#define MK_BRINGUP 0
#endif
namespace pg8 {
#define PG8_LAS __attribute__((address_space(3)))
typedef unsigned short bf16_t;
typedef short bf16x8 __attribute__((ext_vector_type(8)));
typedef float f32x4 __attribute__((ext_vector_type(4)));
typedef unsigned u32x4 __attribute__((ext_vector_type(4)));
constexpr int BM = 256, BK = 64, HALF = 128, HTB = HALF * BK * 2  , STAGE_BYTES = 8 * HTB, NXCD = 8, WGM = 8;

__host__ __device__ __forceinline__ int lds_byte(int r, int c) { const int st = (r >> 4) * 2 + (c >> 5), rr = r & 15, cc = c & 31, ob = rr * 64 + cc * 2; return st * 1024 + (ob ^ (((ob >> 9) & 1) << 5)); }
__host__ __device__ __forceinline__ void stage_rc(int b, int& R, int& C) { const int st = b / 1024, sb = b % 1024, swz = sb ^ (((sb >> 9) & 1) << 5); R = (st >> 1) * 16 + swz / 64; C = (st & 1) * 32 + (swz % 64) / 2; }
__host__ __device__ __forceinline__ int perm32(int rho) { const int n = rho >> 4, i = rho & 15; return 8 * (i >> 2) + 4 * n + (i & 3); }

struct Unit { int pm, pn; };
struct Gemm { const bf16_t* A; const bf16_t* Bt; int M, N, K; int wave = 0; int a_tiled = 0, b_tiled = 0; };

struct StaticOrder {
    int nM, nN, nwg, G, c, wgm;
    __host__ __device__ void init(int M, int N, int G_, int c_, int wgm_ = WGM) { nM = M / BM; nN = N / BM; nwg = nM * nN; G = G_; c = c_; wgm = wgm_; }
    __host__ __device__ bool next(int i, Unit& u) const {
        const long L = (long)i * G + c; if (L >= nwg) return false;
        int wgid = (int)L; { const int q = nwg / NXCD, r = nwg % NXCD, xcd = wgid % NXCD, off = wgid / NXCD; wgid = (xcd < r ? xcd * (q + 1) : r * (q + 1) + (xcd - r) * q) + off; }
        const int nig = wgm * nN, gid = wgid / nig, fm = gid * wgm, gsz = (nM - fm) < wgm ? (nM - fm) : wgm;
        u.pm = fm + ((wgid % nig) % gsz); u.pn = (wgid % nig) / gsz; return true;
    }
    __device__ __forceinline__ void a_ready(const Unit&) const {}
    __device__ __forceinline__ void done(const Unit&) const {}
};

typedef __bf16 bf16x2_hw __attribute__((ext_vector_type(2)));
typedef float f32x2_hw __attribute__((ext_vector_type(2)));
__device__ __forceinline__ unsigned cvt_pk_bf16(float lo, float hi) { const f32x2_hw v = {lo, hi}; const bf16x2_hw r = __builtin_convertvector(v, bf16x2_hw); return __builtin_bit_cast(unsigned, r); }
__device__ __forceinline__ int lane_id_now() { int l; asm volatile("v_mbcnt_lo_u32_b32 %0, -1, 0\n\tv_mbcnt_hi_u32_b32 %0, -1, %0" : "=v"(l)); return l; }
typedef float f32x2 __attribute__((ext_vector_type(2)));
__device__ __forceinline__ float sigmoidf_(float v) { return __builtin_amdgcn_rcpf(1.0f + __builtin_amdgcn_exp2f(-1.4426950408889634f * v)); }
__device__ __forceinline__ f32x4 sigmoid4(f32x4 v) { return (f32x4){sigmoidf_(v[0]), sigmoidf_(v[1]), sigmoidf_(v[2]), sigmoidf_(v[3])}; }
__device__ __forceinline__ u32x4 pack8(f32x4 v0, f32x4 v1) { u32x4 w; w.x = cvt_pk_bf16(v0[0], v0[1]); w.y = cvt_pk_bf16(v0[2], v0[3]); w.z = cvt_pk_bf16(v1[0], v1[1]); w.w = cvt_pk_bf16(v1[2], v1[3]); return w; }
__device__ __forceinline__ void unpack8(u32x4 w, f32x4& v0, f32x4& v1) {
    v0 = (f32x4){__uint_as_float(w.x << 16), __uint_as_float(w.x & 0xffff0000u), __uint_as_float(w.y << 16), __uint_as_float(w.y & 0xffff0000u)};
    v1 = (f32x4){__uint_as_float(w.z << 16), __uint_as_float(w.z & 0xffff0000u), __uint_as_float(w.w << 16), __uint_as_float(w.w & 0xffff0000u)}; }

template <int CTRL> __device__ __forceinline__ float dpp_mov(float v) { return __int_as_float(__builtin_amdgcn_update_dpp(0, __float_as_int(v), CTRL, 0xf, 0xf, true)); }
__device__ __forceinline__ float row16_max(float v) {
    v = fmaxf(v, dpp_mov<0xB1>(v)); v = fmaxf(v, dpp_mov<0x4E>(v)); v = fmaxf(v, dpp_mov<0x141>(v)); v = fmaxf(v, dpp_mov<0x140>(v)); return v; }
__device__ __forceinline__ float row16_sum(float v) {
    v += dpp_mov<0xB1>(v); v += dpp_mov<0x4E>(v); v += dpp_mov<0x141>(v); v += dpp_mov<0x140>(v); return v; }
__device__ __forceinline__ float xrow_sum(float v) {
    { auto r = __builtin_amdgcn_permlane16_swap(__float_as_uint(v), __float_as_uint(v), false, false); v = __uint_as_float(r[0]) + __uint_as_float(r[1]); }
    { auto r = __builtin_amdgcn_permlane32_swap(__float_as_uint(v), __float_as_uint(v), false, false); v = __uint_as_float(r[0]) + __uint_as_float(r[1]); }
    return v; }

template <int ACT  > struct EpiSplitBf16 {
    static constexpr bool PERM = true, AFTER_DRAIN = false; static constexpr int MID_T = 0;
    bf16_t* O; int ldc; int split_cols; size_t split_stride;
    __device__ __forceinline__ void operator()(const f32x4 (&acc)[2][2][4][2], const Unit& u, int wr, int wc, int fr, int fq) const {
        const int row0 = u.pm * BM + wr * 64 + fr; int colt = u.pn * BM; bf16_t* base = O;
        if (split_cols) { const int t = colt / split_cols; base += (size_t)t * split_stride; colt -= t * split_cols; }
        const int col0 = colt + wc * 32 + 8 * fq;
#pragma unroll
        for (int ai = 0; ai < 2; ++ai)
#pragma unroll
            for (int m = 0; m < 4; ++m) { bf16_t* rowp = base + (size_t)(row0 + ai * HALF + m * 16) * ldc + col0;
#pragma unroll
                for (int bj = 0; bj < 2; ++bj) { f32x4 v0 = acc[ai][bj][m][0], v1 = acc[ai][bj][m][1];
                    if (ACT == 1) { v0 = sigmoid4(v0); v1 = sigmoid4(v1); }
                    *(u32x4*)(rowp + bj * HALF) = pack8(v0, v1); } }
    }
};
struct EpiFoxQKV {
    static constexpr bool PERM = true, AFTER_DRAIN = false; static constexpr int MID_T = 0;
    bf16_t* O; unsigned* qn; unsigned* kn;
    __device__ __forceinline__ void operator()(const f32x4 (&acc)[2][2][4][2], const Unit& u, int wr, int wc, int fr, int fq) const {
        const int row0 = u.pm * BM + wr * 64 + fr, t = u.pn >> 2; bf16_t* base = O + (size_t)t * ((size_t)M * 1024);
        const int col0 = (u.pn & 3) * BM + wc * 32 + 8 * fq; float mx[2][2] = {{0.f, 0.f}, {0.f, 0.f}};
#pragma unroll
        for (int ai = 0; ai < 2; ++ai)
#pragma unroll
            for (int m = 0; m < 4; ++m) { bf16_t* rowp = base + (size_t)(row0 + ai * HALF + m * 16) * 1024 + col0;
#pragma unroll
                for (int bj = 0; bj < 2; ++bj) { const f32x4 v0 = acc[ai][bj][m][0], v1 = acc[ai][bj][m][1];
                    *(u32x4*)(rowp + bj * HALF) = pack8(v0, v1);
                    float s = (v0[0] * v0[0] + v0[1] * v0[1]) + (v0[2] * v0[2] + v0[3] * v0[3]) + (v1[0] * v1[0] + v1[1] * v1[1]) + (v1[2] * v1[2] + v1[3] * v1[3]);
                    s = xrow_sum(s);
                    mx[bj][ai] = fmaxf(mx[bj][ai], s); } }
        if (t < 2) {
#pragma unroll
            for (int bj = 0; bj < 2; ++bj)
#pragma unroll
                for (int ai = 0; ai < 2; ++ai) mx[bj][ai] = row16_max(mx[bj][ai]);
            if (fr == 0 && fq == 0) { const int b = u.pm >> 5, qb = u.pm & 31, h0 = 2 * (u.pn & 3);
#pragma unroll
                for (int bj = 0; bj < 2; ++bj) { const int bh = b * 8 + h0 + bj;
                    if (t == 0) __hip_atomic_fetch_max(qn + ((bh * 32 + qb) * 4 + wc), __float_as_uint(fmaxf(mx[bj][0], mx[bj][1])), __ATOMIC_RELAXED, __HIP_MEMORY_SCOPE_AGENT);
                    else {
#pragma unroll
                        for (int ai = 0; ai < 2; ++ai) __hip_atomic_fetch_max(kn + ((bh * 128 + qb * 4 + 2 * ai + wr) * 4 + wc), __float_as_uint(mx[bj][ai]), __ATOMIC_RELAXED, __HIP_MEMORY_SCOPE_AGENT); } } }
        }
    }
};
struct EpiSwiGLU {
    static constexpr bool PERM = true, AFTER_DRAIN = false; static constexpr int MID_T = 0;
    bf16_t* H; int ldc;
    __device__ __forceinline__ void operator()(const f32x4 (&acc)[2][2][4][2], const Unit& u, int wr, int wc, int fr, int fq) const {
        const int row0 = u.pm * BM + wr * 64 + fr, col0 = u.pn * HALF + wc * 32 + 8 * fq;
#pragma unroll
        for (int ai = 0; ai < 2; ++ai)
#pragma unroll
            for (int m = 0; m < 4; ++m) { const int row = row0 + ai * HALF + m * 16;
                bf16_t* rowp = H + ((size_t)(row >> 8) * (ldc >> 6) + (col0 >> 6)) * (size_t)(BM * BK) + (row & 255) * BK + (col0 & 63);
                const f32x4 a0 = acc[ai][0][m][0], a1 = acc[ai][0][m][1], b0 = acc[ai][1][m][0], b1 = acc[ai][1][m][1];
                const f32x4 v0 = a0 * sigmoid4(a0) * b0, v1 = a1 * sigmoid4(a1) * b1;
                *(u32x4*)rowp = pack8(v0, v1); }
    }
};
struct EpiRope {
    static constexpr bool PERM = true, AFTER_DRAIN = false; static constexpr int MID_T = 0;
    bf16_t* QB; bf16_t* KB; const float* cosT; const float* sinT;
    __device__ __forceinline__ void operator()(const f32x4 (&acc)[2][2][4][2], const Unit& u, int wr, int wc, int fr, int fq) const {
        const int row0 = u.pm * BM + wr * 64 + fr; const int tsel = u.pn / 6, pnl = u.pn - tsel * 6;
        bf16_t* base = tsel ? KB : QB; const int dd0 = 32 * (wc & 1) + 8 * fq, head = 2 * pnl + (wc >> 1);
#pragma unroll
        for (int ai = 0; ai < 2; ++ai)
#pragma unroll
            for (int m = 0; m < 4; ++m) { const int row = row0 + ai * HALF + m * 16, pos = row & (SEQ - 1);
                const f32x4 c0 = *(const f32x4*)(cosT + pos * 64 + dd0), c1 = *(const f32x4*)(cosT + pos * 64 + dd0 + 4);
                const f32x4 s0 = *(const f32x4*)(sinT + pos * 64 + dd0), s1 = *(const f32x4*)(sinT + pos * 64 + dd0 + 4);
                const f32x4 x10 = acc[ai][0][m][0], x11 = acc[ai][0][m][1], x20 = acc[ai][1][m][0], x21 = acc[ai][1][m][1];
                bf16_t* rowp = base + (size_t)row * 1536 + head * 128 + dd0;
                *(u32x4*)rowp = pack8(x10 * c0 - x20 * s0, x11 * c1 - x21 * s1);
                *(u32x4*)(rowp + 64) = pack8(x20 * c0 + x10 * s0, x21 * c1 + x11 * s1);
                asm volatile("" ::: "memory"); }
    }
};
template <int MODE> struct EpiGate {
    static constexpr bool PERM = true, AFTER_DRAIN = false; static constexpr int MID_T = 0;
    const bf16_t* G; bf16_t* T;
    __device__ __forceinline__ void operator()(const f32x4 (&acc)[2][2][4][2], const Unit& u, int wr, int wc, int fr, int fq) const {
        const int row0 = u.pm * BM + wr * 64 + fr, col0 = u.pn * BM + wc * 32 + 8 * fq;
#pragma unroll
        for (int ai = 0; ai < 2; ++ai)
#pragma unroll
            for (int m = 0; m < 4; ++m) { const size_t off = (size_t)(row0 + ai * HALF + m * 16) * 2048 + col0;
#pragma unroll
                for (int bj = 0; bj < 2; ++bj) { f32x4 g0, g1; unpack8(*(const u32x4*)(G + off + bj * HALF), g0, g1);
                    f32x4 v0 = g0 * acc[ai][bj][m][0], v1 = g1 * acc[ai][bj][m][1];
                    if (MODE == 1) { f32x4 t0, t1; unpack8(*(const u32x4*)(T + off + bj * HALF), t0, t1); v0 += t0; v1 += t1; }
                    *(u32x4*)(T + off + bj * HALF) = pack8(v0, v1); }
                asm volatile("" ::: "memory"); }
    }
};
struct EpiGates {
    static constexpr bool PERM = true, AFTER_DRAIN = false; static constexpr int MID_T = 0;
    bf16_t* R; bf16_t* GB;
    __device__ __forceinline__ void operator()(const f32x4 (&acc)[2][2][4][2], const Unit& u, int wr, int wc, int fr, int fq) const {
        const int row0 = u.pm * BM + wr * 64 + fr, col0 = u.pn * HALF + wc * 32 + 8 * fq;
#pragma unroll
        for (int ai = 0; ai < 2; ++ai)
#pragma unroll
            for (int m = 0; m < 4; ++m) { const size_t off = (size_t)(row0 + ai * HALF + m * 16) * 2048 + col0; f32x4 r[2], g[2];
#pragma unroll
                for (int n = 0; n < 2; ++n)
#pragma unroll
                    for (int e_ = 0; e_ < 4; ++e_) { const float ea = __builtin_amdgcn_exp2f(-1.4426950408889634f * acc[ai][0][m][n][e_]), eb = __builtin_amdgcn_exp2f(-1.4426950408889634f * acc[ai][1][m][n][e_]);
                        g[n][e_] = __builtin_amdgcn_rcpf(1.0f + eb); r[n][e_] = (1.0f + eb) * __builtin_amdgcn_rcpf(1.0f + ea); }
                *(u32x4*)(R + off) = pack8(r[0], r[1]); *(u32x4*)(GB + off) = pack8(g[0], g[1]); }
    }
};
struct EpiMixOut {
    static constexpr bool PERM = true, AFTER_DRAIN = false; static constexpr int MID_T = 16;
    const bf16_t* GA; const bf16_t* GB; bf16_t* T;
    __device__ __forceinline__ void mid(f32x4 (&acc)[2][2][4][2], const Unit& u, int wr, int wc, int fr, int fq) const {
        const int row0 = u.pm * BM + wr * 64 + fr, col0 = u.pn * BM + wc * 32 + 8 * fq;
        u32x4 r[2][4][2];
#pragma unroll
        for (int ai = 0; ai < 2; ++ai)
#pragma unroll
            for (int m = 0; m < 4; ++m) { const size_t off = (size_t)(row0 + ai * HALF + m * 16) * 2048 + col0;
#pragma unroll
                for (int bj = 0; bj < 2; ++bj) r[ai][m][bj] = *(const u32x4*)(GA + off + bj * HALF); }
#pragma unroll
        for (int ai = 0; ai < 2; ++ai)
#pragma unroll
            for (int m = 0; m < 4; ++m)
#pragma unroll
                for (int bj = 0; bj < 2; ++bj) { f32x4 a0, a1; unpack8(r[ai][m][bj], a0, a1); acc[ai][bj][m][0] *= a0; acc[ai][bj][m][1] *= a1; }
    }
    __device__ __forceinline__ void operator()(const f32x4 (&acc)[2][2][4][2], const Unit& u, int wr, int wc, int fr, int fq) const {
        const int row0 = u.pm * BM + wr * 64 + fr, col0 = u.pn * BM + wc * 32 + 8 * fq;
u32x4 r[2][4][2];
#pragma unroll
        for (int ai = 0; ai < 2; ++ai)
#pragma unroll
            for (int m = 0; m < 4; ++m) { const size_t off = (size_t)(row0 + ai * HALF + m * 16) * 2048 + col0;
#pragma unroll
                for (int bj = 0; bj < 2; ++bj) r[ai][m][bj] = *(const u32x4*)(GB + off + bj * HALF); }
#pragma unroll
        for (int ai = 0; ai < 2; ++ai)
#pragma unroll
            for (int m = 0; m < 4; ++m) { const size_t off = (size_t)(row0 + ai * HALF + m * 16) * 2048 + col0;
#pragma unroll
                for (int bj = 0; bj < 2; ++bj) { f32x4 b0, b1; unpack8(r[ai][m][bj], b0, b1);
                    *(u32x4*)(T + off + bj * HALF) = pack8(acc[ai][bj][m][0] * b0, acc[ai][bj][m][1] * b1); } }
    }
};
struct EpiPle {
    static constexpr bool PERM = true, AFTER_DRAIN = false; static constexpr int MID_T = 0;
    const bf16_t* E; bf16_t* O;
    __device__ __forceinline__ void operator()(const f32x4 (&acc)[2][2][4][2], const Unit& u, int wr, int wc, int fr, int fq) const {
        const int row0 = u.pm * BM + wr * 64 + fr, col0 = u.pn * BM + wc * 32 + 8 * fq;
u32x4 r[2][4][2];
#pragma unroll
        for (int ai = 0; ai < 2; ++ai)
#pragma unroll
            for (int m = 0; m < 4; ++m) { const size_t off = (size_t)(row0 + ai * HALF + m * 16) * 2048 + col0;
#pragma unroll
                for (int bj = 0; bj < 2; ++bj) r[ai][m][bj] = *(const u32x4*)(E + off + bj * HALF); }
#pragma unroll
        for (int ai = 0; ai < 2; ++ai)
#pragma unroll
            for (int m = 0; m < 4; ++m) { const size_t off = (size_t)(row0 + ai * HALF + m * 16) * 2048 + col0;
#pragma unroll
                for (int bj = 0; bj < 2; ++bj) { f32x4 e0, e1; unpack8(r[ai][m][bj], e0, e1);
                    *(u32x4*)(O + off + bj * HALF) = pack8(sigmoid4(acc[ai][bj][m][0]) * e0, sigmoid4(acc[ai][bj][m][1]) * e1); } }
    }
};
template <int MODE> struct EpiF32 {
    static constexpr bool PERM = false, AFTER_DRAIN = false; static constexpr int MID_T = 0;
    float* C; int ldc;
    __device__ __forceinline__ void operator()(const f32x4 (&acc)[2][2][4][2], const Unit& u, int wr, int wc, int fr, int fq) const {
        const int row0 = u.pm * BM + wr * 64 + fr, col0 = u.pn * BM + wc * 32 + 4 * fq;
#pragma unroll
        for (int ai = 0; ai < 2; ++ai)
#pragma unroll
            for (int m = 0; m < 4; ++m) { float* rowp = C + (size_t)(row0 + ai * HALF + m * 16) * ldc + col0;
#pragma unroll
                for (int bj = 0; bj < 2; ++bj) {
#pragma unroll
                    for (int n = 0; n < 2; ++n) { f32x4 v = acc[ai][bj][m][n];
                        if (MODE == 1) { v = sigmoid4(v) * *(const f32x4*)(rowp + bj * HALF + n * 16); }
                        *(f32x4*)(rowp + bj * HALF + n * 16) = v; }
                    if (MODE == 1) asm volatile("" ::: "memory"); } }
    }
};

template <class Epi, class Sched, bool ALIGN_EPI = false, bool SP2 = false>
__device__ __forceinline__ void gemm_phase(PG8_LAS unsigned char* lds, const Gemm g, const Sched& S, const Epi& E) {
    const int tid_ = g.wave * 64 + lane_id_now();
    const int tid = tid_, wid = __builtin_amdgcn_readfirstlane(g.wave), lane = tid & 63, wr = wid >> 2, wc = wid & 3, fr = lane & 15, fq = lane >> 4;
    __builtin_amdgcn_s_waitcnt(0);
    const int K = g.K, nt = K / BK;
    unsigned voffA[2], voffB[2];
#pragma unroll
    for (int i = 0; i < 2; ++i) { int R, C; stage_rc(tid * 16 + i * 8192, R, C); const int Rb = Epi::PERM ? ((R & ~31) + perm32(R & 31)) : R;
        voffA[i] = (unsigned)(R * (g.a_tiled ? BK : K) + C) * 2u; voffB[i] = (unsigned)(Rb * (g.b_tiled ? BK : K) + C) * 2u; }
    const size_t kstep = (size_t)(BK * 2);
    const size_t hstep = (size_t)HALF * K * 2;
    const size_t tstep = 2 * hstep;
    const size_t kstepA = g.a_tiled ? (size_t)(BM * BK * 2) : kstep, hstepA = g.a_tiled ? (size_t)(HALF * BK * 2) : hstep;
    const size_t kstepB = g.b_tiled ? (size_t)(BM * BK * 2) : kstep, hstepB = g.b_tiled ? (size_t)(HALF * BK * 2) : hstep;
    const unsigned ldsw = (unsigned)wid * 1024u;
    const int aoff = lds_byte(wr * 64 + fr, fq * 8), boff = lds_byte(wc * 32 + fr, fq * 8);
#define PG8_SA(b, h) (((b) * 2 + (h)) * HTB)
#define PG8_SB(b, h) ((4 + (b) * 2 + (h)) * HTB)
#define PG8_STAGE(bufoff, gbase, voff) do { _Pragma("unroll") for (int _i = 0; _i < 2; ++_i) \
        __builtin_amdgcn_global_load_lds((const unsigned*)((const char*)(gbase) + (voff)[_i]), (PG8_LAS unsigned*)(lds + (bufoff) + ldsw + _i * 8192), 16, 0, 0); } while (0)
#define PG8_LDA(dst, b, h) do { _Pragma("unroll") for (int m = 0; m < 4; ++m) _Pragma("unroll") for (int k = 0; k < 2; ++k) dst[m][k] = *(const PG8_LAS bf16x8*)(lds + PG8_SA(b, h) + aoff + m * 2048 + k * 1024); } while (0)
#define PG8_LDB(dst, b, h) do { _Pragma("unroll") for (int n = 0; n < 2; ++n) _Pragma("unroll") for (int k = 0; k < 2; ++k) dst[n][k] = *(const PG8_LAS bf16x8*)(lds + PG8_SB(b, h) + boff + n * 2048 + k * 1024); } while (0)
#define PG8_MMA(ai, bj, At, Bt) do { __builtin_amdgcn_s_setprio(1); _Pragma("unroll") for (int m = 0; m < 4; ++m) _Pragma("unroll") for (int n = 0; n < 2; ++n) _Pragma("unroll") for (int k = 0; k < 2; ++k) \
        acc[ai][bj][m][n] = __builtin_amdgcn_mfma_f32_16x16x32_bf16(Bt[n][k], At[m][k], acc[ai][bj][m][n], 0, 0, 0); __builtin_amdgcn_s_setprio(0); } while (0)
#define PG8_WAIT_V(n) asm volatile("s_waitcnt vmcnt(" #n ")" ::: "memory")
#define PG8_WAIT_L(n) asm volatile("s_waitcnt lgkmcnt(" #n ")" ::: "memory")
#define PG8_BAR __builtin_amdgcn_s_barrier()
#define PG8_SCHED __builtin_amdgcn_sched_barrier(0)
    Unit cur, nxt; int ui = 0;
    if (!S.next(0, cur)) return;
    f32x4 acc[2][2][4][2];
#pragma unroll
    for (int a = 0; a < 2; ++a)
#pragma unroll
        for (int b = 0; b < 2; ++b)
#pragma unroll
            for (int m = 0; m < 4; ++m)
#pragma unroll
                for (int n = 0; n < 2; ++n) acc[a][b][m][n] = (f32x4){0.f, 0.f, 0.f, 0.f};
    bf16x8 At[4][2], B0[2][2], B1[2][2];
    const char* cA = (const char*)g.A + (size_t)cur.pm * tstep; const char* cB = (const char*)g.Bt + (size_t)cur.pn * tstep;
    S.a_ready(cur);
    if constexpr (SP2) {
        PG8_STAGE(PG8_SB(0, 0), cB, voffB); PG8_STAGE(PG8_SB(0, 1), cB + hstepB, voffB); PG8_STAGE(PG8_SA(0, 0), cA, voffA); PG8_STAGE(PG8_SA(0, 1), cA + hstepA, voffA);
        if (wr == 1) PG8_BAR;
        PG8_WAIT_V(2); PG8_BAR;
        PG8_STAGE(PG8_SB(1, 0), cB + kstepB, voffB); PG8_STAGE(PG8_SA(1, 0), cA + kstepA, voffA); PG8_STAGE(PG8_SB(1, 1), cB + hstepB + kstepB, voffB);
        PG8_WAIT_V(6); PG8_BAR;
    } else {
        PG8_STAGE(PG8_SB(0, 0), cB, voffB); PG8_STAGE(PG8_SA(0, 0), cA, voffA); PG8_STAGE(PG8_SB(0, 1), cB + hstepB, voffB); PG8_STAGE(PG8_SA(0, 1), cA + hstepA, voffA);
        if (wr == 1) PG8_BAR;
        PG8_WAIT_V(4); PG8_BAR;
        PG8_STAGE(PG8_SB(1, 0), cB + kstepB, voffB); PG8_STAGE(PG8_SA(1, 0), cA + kstepA, voffA); PG8_STAGE(PG8_SB(1, 1), cB + hstepB + kstepB, voffB);
        PG8_WAIT_V(6); PG8_BAR;
    }
    for (;;) {
        const bool has_next = S.next(ui + 1, nxt);
        const char* nA = has_next ? (const char*)g.A + (size_t)nxt.pm * tstep : cA; const char* nB = has_next ? (const char*)g.Bt + (size_t)nxt.pn * tstep : cB;
        for (int t = 0; t < nt; t += 2) {
            const bool last = (t == nt - 2);
            const char* a1 = cA + (size_t)(t + 1) * kstepA;
            const char* a2 = last ? nA : cA + (size_t)(t + 2) * kstepA; const char* b2 = last ? nB : cB + (size_t)(t + 2) * kstepB;
            const char* a3 = a2 + kstepA; const char* b3 = b2 + kstepB;
            if (last && has_next) S.a_ready(nxt);
            if constexpr (Epi::MID_T > 0) { if (t == Epi::MID_T) {
                const int l_ = lane_id_now(); E.mid(acc, cur, wr, wc, l_ & 15, l_ >> 4); } }
            if constexpr (SP2) {
            PG8_LDB(B0, 0, 0); PG8_LDB(B1, 0, 1); PG8_SCHED; PG8_LDA(At, 0, 0); PG8_STAGE(PG8_SA(1, 1), a1 + hstepA, voffA);
            PG8_WAIT_V(8); PG8_WAIT_L(0); PG8_BAR; PG8_MMA(0, 0, At, B0); PG8_MMA(0, 1, At, B1); PG8_BAR; PG8_SCHED;
            PG8_LDA(At, 0, 1); PG8_STAGE(PG8_SB(0, 0), b2, voffB); PG8_STAGE(PG8_SB(0, 1), b2 + hstepB, voffB); PG8_STAGE(PG8_SA(0, 0), a2, voffA);
            PG8_WAIT_V(8); PG8_WAIT_L(0); PG8_BAR; PG8_MMA(1, 0, At, B0); PG8_MMA(1, 1, At, B1); PG8_BAR; PG8_SCHED;
            PG8_LDB(B0, 1, 0); PG8_LDB(B1, 1, 1); PG8_SCHED; PG8_LDA(At, 1, 0); PG8_STAGE(PG8_SA(0, 1), a2 + hstepA, voffA);
            PG8_WAIT_V(8); PG8_WAIT_L(0); PG8_BAR; PG8_MMA(0, 0, At, B0); PG8_MMA(0, 1, At, B1); PG8_BAR; PG8_SCHED;
            PG8_LDA(At, 1, 1); PG8_STAGE(PG8_SB(1, 0), b3, voffB); PG8_STAGE(PG8_SB(1, 1), b3 + hstepB, voffB); PG8_STAGE(PG8_SA(1, 0), a3, voffA);
            PG8_WAIT_V(8); PG8_WAIT_L(0); PG8_BAR; PG8_MMA(1, 0, At, B0); PG8_MMA(1, 1, At, B1); PG8_BAR; PG8_SCHED;
            } else {
            PG8_LDB(B0, 0, 0); PG8_SCHED; PG8_LDA(At, 0, 0); PG8_STAGE(PG8_SA(1, 1), a1 + hstepA, voffA);
            PG8_WAIT_L(8); PG8_BAR; PG8_WAIT_L(0); PG8_MMA(0, 0, At, B0); PG8_BAR; PG8_SCHED;
            PG8_LDB(B1, 0, 1); PG8_STAGE(PG8_SB(0, 0), b2, voffB);
            PG8_BAR; PG8_WAIT_L(0); PG8_MMA(0, 1, At, B1); PG8_BAR;
            PG8_LDA(At, 0, 1); PG8_STAGE(PG8_SA(0, 0), a2, voffA);
            PG8_BAR; PG8_WAIT_L(0); PG8_MMA(1, 0, At, B0); PG8_BAR; PG8_SCHED;
            PG8_STAGE(PG8_SB(0, 1), b2 + hstepB, voffB);
            PG8_WAIT_V(6); PG8_BAR; PG8_MMA(1, 1, At, B1); PG8_BAR;
            PG8_LDB(B0, 1, 0); PG8_SCHED; PG8_LDA(At, 1, 0); PG8_STAGE(PG8_SA(0, 1), a2 + hstepA, voffA);
            PG8_WAIT_L(8); PG8_BAR; PG8_WAIT_L(0); PG8_MMA(0, 0, At, B0); PG8_BAR; PG8_SCHED;
            PG8_LDB(B1, 1, 1); PG8_STAGE(PG8_SB(1, 0), b3, voffB);
            PG8_BAR; PG8_WAIT_L(0); PG8_MMA(0, 1, At, B1); PG8_BAR;
            PG8_LDA(At, 1, 1); PG8_STAGE(PG8_SA(1, 0), a3, voffA);
            PG8_BAR; PG8_WAIT_L(0); PG8_MMA(1, 0, At, B0); PG8_BAR; PG8_SCHED;
            PG8_STAGE(PG8_SB(1, 1), b3 + hstepB, voffB);
            PG8_WAIT_V(6); PG8_BAR; PG8_MMA(1, 1, At, B1); PG8_BAR;
            }
        }
        if constexpr (ALIGN_EPI) { if (wr == 0) PG8_BAR; }
        if constexpr (!Epi::AFTER_DRAIN) { const int l_ = lane_id_now();
            E(acc, cur, wr, wc, l_ & 15, l_ >> 4); S.done(cur); }
        if (!has_next) break;
#pragma unroll
        for (int a = 0; a < 2; ++a)
#pragma unroll
            for (int b = 0; b < 2; ++b)
#pragma unroll
                for (int m = 0; m < 4; ++m)
#pragma unroll
                    for (int n = 0; n < 2; ++n) acc[a][b][m][n] = (f32x4){0.f, 0.f, 0.f, 0.f};
        cur = nxt; cA = nA; cB = nB; ++ui;
        if constexpr (ALIGN_EPI) { if (wr == 1) PG8_BAR; }
    }
    PG8_WAIT_V(0);
    if constexpr (!ALIGN_EPI) { if (wr == 0) PG8_BAR; }
    PG8_BAR;
    if constexpr (Epi::AFTER_DRAIN) { E.fused(acc, cur, wr, wc, fr, fq, lds, wid, lane); S.done(cur); }
#undef PG8_SA
#undef PG8_SB
#undef PG8_STAGE
#undef PG8_LDA
#undef PG8_LDB
#undef PG8_MMA
#undef PG8_WAIT_V
#undef PG8_WAIT_L
#undef PG8_BAR
#undef PG8_SCHED
}
}
#define GAS __attribute__((address_space(1)))
#define LAS __attribute__((address_space(3)))
typedef unsigned short bf16;
typedef unsigned v4u __attribute__((ext_vector_type(4)));
typedef float f32x4 __attribute__((ext_vector_type(4)));
typedef short bf16x8 __attribute__((ext_vector_type(8)));
typedef GAS unsigned gu32;
typedef GAS unsigned long long gu64;
#define RLX_AGENT __ATOMIC_RELAXED, __HIP_MEMORY_SCOPE_AGENT
#define LDS_WAIT() asm volatile("s_waitcnt lgkmcnt(0)" ::: "memory")
#define VM_WAIT() asm volatile("s_waitcnt vmcnt(0)" ::: "memory")
__device__ __forceinline__ unsigned long long rt() { return __builtin_amdgcn_s_memrealtime(); }
__device__ __forceinline__ unsigned f2bf(float f) { unsigned u = __builtin_bit_cast(unsigned, f); return (u + 0x7fffu + ((u >> 16) & 1u)) >> 16; }
__device__ __forceinline__ unsigned pk2(float lo, float hi) { return f2bf(lo) | (f2bf(hi) << 16); }

#define XB_TMO      128
#define XB_XCNT(j)  (256  + 64 * (j))
#define XB_XSUB(j)  (1280 + 64 * (j))
#define XB_XGEN(j)  (2304 + 64 * (j))
#define XB_TOP      3328
#define XB_TOPGEN   3392
#define XCD_BAR_WORDS 3456
#define XB_SPIN_CAP (1u << 18)

__device__ __forceinline__ unsigned xb_ld(unsigned* p)              { return __hip_atomic_load(p, __ATOMIC_RELAXED, __HIP_MEMORY_SCOPE_AGENT); }
__device__ __forceinline__ unsigned xb_add(unsigned* p, unsigned v) { return __hip_atomic_fetch_add(p, v, __ATOMIC_RELAXED, __HIP_MEMORY_SCOPE_AGENT); }
__device__ __forceinline__ unsigned xb_xcc_id() { return (unsigned)__builtin_amdgcn_s_getreg((3 << 11) | 20) & 0xFu; }
#define XB_SPIN(cond, bar) do { unsigned _sp = 0; while (cond) { __builtin_amdgcn_s_sleep(1); \
    if ((++_sp & 255u) == 0u) { if (xb_ld(&(bar)[XB_TMO])) break; if (_sp > XB_SPIN_CAP) { atomicAdd(&(bar)[XB_TMO], 1u); break; } } } } while (0)

struct XcdBarrier {
    unsigned* bar; unsigned x; int wave;
    volatile LAS unsigned* st;
};

__device__ __forceinline__ XcdBarrier xcd_barrier_post(unsigned* bar, volatile LAS unsigned* st) {
    XcdBarrier b; b.bar = bar; b.x = xb_xcc_id(); b.st = st;
    if (threadIdx.x == 0) (void)xb_add(&bar[XB_XCNT(b.x)], 1u);
    return b;
}
__device__ __forceinline__ void xcd_barrier_complete(unsigned* bar, unsigned x, unsigned& nloc, unsigned& nx) {
    const unsigned G = gridDim.x * gridDim.y * gridDim.z;
    unsigned sum, cnt, mine, sp = 0u;
    for (;;) {
        sum = 0u; cnt = 0u; mine = 0u;
#pragma unroll
        for (unsigned j = 0; j < 16; ++j) { const unsigned c = xb_ld(&bar[XB_XCNT(j)]); sum += c; cnt += (c > 0u) ? 1u : 0u; mine = (j == x) ? c : mine; }
        if (sum == G) break;
        __builtin_amdgcn_s_sleep(1);
        if ((++sp & 255u) == 0u) { if (xb_ld(&bar[XB_TMO])) break; if (sp > XB_SPIN_CAP) { atomicAdd(&bar[XB_TMO], 1u); break; } }
    }
    nloc = mine > 0u ? mine : 1u; nx = cnt > 0u ? cnt : 1u;
}

__device__ __forceinline__ void xcd_barrier(const XcdBarrier& b) {
    asm volatile("s_waitcnt vmcnt(0)" ::: "memory");
    __syncthreads();
    const int t0_ = b.wave * 64 + pg8::lane_id_now();
    if (t0_ == 0) {
        size_t zb_ = 0; unsigned bx_ = b.x; asm volatile("" : "+s"(zb_), "+s"(bx_)); unsigned* bar = b.bar + zb_;
        __builtin_amdgcn_s_waitcnt(0);
        unsigned nloc = b.st[0], nx = b.st[1];
        if (nloc == 0u) { xcd_barrier_complete(bar, bx_, nloc, nx); b.st[0] = nloc; b.st[1] = nx; }
        const unsigned old = xb_add(&bar[XB_XSUB(bx_)], 1u);
        const unsigned gen = old / nloc;
        if (old + 1u == (gen + 1u) * nloc) {
            __builtin_amdgcn_fence(__ATOMIC_RELEASE, "agent");
            asm volatile("s_waitcnt vmcnt(0)" ::: "memory");
            const unsigned og = xb_add(&bar[XB_TOP], 1u);
            const unsigned tg = og / nx;
            if (og + 1u == (tg + 1u) * nx) xb_add(&bar[XB_TOPGEN], 1u);
            else XB_SPIN(xb_ld(&bar[XB_TOPGEN]) == tg, bar);
            __builtin_amdgcn_fence(__ATOMIC_ACQUIRE, "agent");
            xb_add(&bar[XB_XGEN(bx_)], 1u);
            asm volatile("s_waitcnt vmcnt(0)" ::: "memory");
        } else {
            XB_SPIN(xb_ld(&bar[XB_XGEN(bx_)]) == gen, bar);
            __builtin_amdgcn_fence(__ATOMIC_ACQUIRE, "agent");
            asm volatile("s_waitcnt vmcnt(0)" ::: "memory");
        }
    }
    __syncthreads();
}
#ifndef MK_NAIVE_ATTN
#define MK_NAIVE_ATTN 0
#endif
namespace att {
typedef short bf16x8 __attribute__((ext_vector_type(8)));
typedef short s16x4 __attribute__((ext_vector_type(4)));
typedef float f32x16 __attribute__((ext_vector_type(16)));
constexpr float SCALE = 0.08838834764831845f, LOG2E = 1.4426950408889634f, THR = 8.f;
constexpr int D = 128, NW = 8, QBLK = 32, KVBLK = 64, QB = NW * QBLK;
constexpr int SHM_V = KVBLK * D * 2, SHM_K = KVBLK * D * 2;
constexpr int OFF_WS = 2 * SHM_V + 2 * SHM_K, OFF_BIAS = OFF_WS + NW * 64 * 4, OFF_QSLOT = OFF_BIAS + 2 * 64 * 4, ATT_LDS_BYTES = OFF_QSLOT + 16;
#define KSWZ(row, colB) ((row) * 256 + ((colB) ^ (((row) & 7) << 4)))
#define SBAR() __builtin_amdgcn_sched_barrier(0)
__device__ __forceinline__ int v_st(int k, int c) { const int kk = (k & ~0xC) | ((k & 4) << 1) | ((k & 8) >> 1); return ((kk >> 3) * 4 + (c >> 5)) * 512 + ((kk & 7) * 32 + (c & 31)) * 2; }
__device__ __forceinline__ int v_rd_base(int lane) { return ((lane & 3) << 3) | (((lane >> 2) & 3) << 6) | (((lane >> 4) & 1) << 5) | (((lane >> 5) & 1) << 8); }
constexpr int v_rd_off(int d0, int ks, int half) { return d0 * 512 + ks * 4096 + half * 2048; }
__device__ __forceinline__ int crow(int r, int hi) { return (r & 3) + 8 * (r >> 2) + 4 * hi; }
__device__ __forceinline__ unsigned cvtpk(float lo, float hi) { return pg8::cvt_pk_bf16(lo, hi); }
__device__ __forceinline__ bf16x8 load8(const bf16* p) { return *reinterpret_cast<const bf16x8*>(p); }
__device__ __forceinline__ void mask_tile(f32x16& p0, f32x16& p1, int dq, unsigned W) {
    const float NEG = -__builtin_inff();
#pragma unroll
    for (int r = 0; r < 16; ++r) {
        const int c = (r & 3) + 8 * (r >> 2);
        if ((unsigned)(dq - c) >= W) p0[r] = NEG;
        if ((unsigned)(dq - c - 32) >= W) p1[r] = NEG;
    }
}
template <bool FOX>
__device__ __forceinline__ void partialSM(f32x16& p0, f32x16& p1, float& m_reg, float& mn, float& alpha) {
    constexpr float C2 = LOG2E * SCALE;
    float pmax = p0[0]; for (int r = 1; r < 16; ++r) pmax = fmaxf(pmax, p0[r]); for (int r = 0; r < 16; ++r) pmax = fmaxf(pmax, p1[r]);
    { auto rr = __builtin_amdgcn_permlane32_swap(__float_as_uint(pmax), __float_as_uint(pmax), false, false);
      pmax = fmaxf(__uint_as_float(rr[0]), __uint_as_float(rr[1])); }
    if (__builtin_expect(__all((pmax - m_reg) * SCALE <= THR), 1)) { mn = m_reg; alpha = 1.f; }
    else { mn = fmaxf(m_reg, pmax); alpha = __builtin_amdgcn_exp2f((m_reg - mn) * C2); m_reg = mn; }
    const float mnL = -mn * C2;
    for (int r = 0; r < 16; ++r) p0[r] = fmaf(p0[r], C2, mnL); for (int r = 0; r < 16; ++r) p1[r] = fmaf(p1[r], C2, mnL);
    for (int r = 0; r < 16; ++r) p0[r] = __builtin_amdgcn_exp2f(p0[r]);
}
__device__ __forceinline__ void finishSM(f32x16& p0, f32x16& p1, float alpha, float& l_reg, bf16x8& pa0, bf16x8& pa1, bf16x8& pa2, bf16x8& pa3) {
    for (int r = 0; r < 16; ++r) p1[r] = __builtin_amdgcn_exp2f(p1[r]);
    float ps = 0; for (int r = 0; r < 16; ++r) ps += p0[r]; for (int r = 0; r < 16; ++r) ps += p1[r];
    { auto rr = __builtin_amdgcn_permlane32_swap(__float_as_uint(ps), __float_as_uint(ps), false, false);
      ps = __uint_as_float(rr[0]) + __uint_as_float(rr[1]); }
    l_reg = l_reg * alpha + ps;
#define PK4(P, B_, OUT) do { unsigned a0 = cvtpk(P[B_+0], P[B_+1]), a1 = cvtpk(P[B_+2], P[B_+3]);                          \
        unsigned b0 = cvtpk(P[B_+4], P[B_+5]), b1 = cvtpk(P[B_+6], P[B_+7]);                                             \
        auto r0 = __builtin_amdgcn_permlane32_swap(a0, b0, false, false); auto r1 = __builtin_amdgcn_permlane32_swap(a1, b1, false, false); \
        v4u w = {r0[0], r1[0], r0[1], r1[1]}; OUT = *reinterpret_cast<bf16x8*>(&w); } while (0)
    PK4(p0, 0, pa0); PK4(p0, 8, pa1); PK4(p1, 0, pa2); PK4(p1, 8, pa3);
#undef PK4
}
template <int KB, bool SK, bool FOX>
__device__ __forceinline__ void qkt(f32x16& p0, f32x16& p1, const char* K_lds, int r32, int hi, const bf16x8* qr, bool act, const float* bias) {
    if (SK && !act) { const float NEG = -__builtin_inff();
#pragma unroll
        for (int r = 0; r < 16; ++r) { p0[r] = NEG; p1[r] = NEG; } return; }
    if constexpr (FOX) {
#pragma unroll
        for (int g = 0; g < 4; ++g) { const f32x4 b0 = *(const f32x4*)(bias + KB * 64 + 8 * g + 4 * hi), b1 = *(const f32x4*)(bias + KB * 64 + 32 + 8 * g + 4 * hi);
#pragma unroll
            for (int e = 0; e < 4; ++e) { p0[4 * g + e] = b0[e]; p1[4 * g + e] = b1[e]; } }
    } else { p0 = f32x16{}; p1 = f32x16{}; }
    const char* kb[4];
#pragma unroll
    for (int dd = 0; dd < 4; ++dd) kb[dd] = K_lds + KB * SHM_K + KSWZ(r32, (dd * 16 + hi * 8) * 2);
#pragma unroll
    for (int d0 = 0; d0 < 8; ++d0) { const char* a = kb[d0 & 3] + (d0 >> 2) * 128;
        bf16x8 b0 = *reinterpret_cast<const bf16x8*>(a);
        bf16x8 b1 = *reinterpret_cast<const bf16x8*>(a + 32 * 256);
        p0 = __builtin_amdgcn_mfma_f32_32x32x16_bf16(b0, qr[d0], p0, 0, 0, 0);
        p1 = __builtin_amdgcn_mfma_f32_32x32x16_bf16(b1, qr[d0], p1, 0, 0, 0); }
}
template <int VB, bool SK>
__device__ __forceinline__ void pv_tile(f32x16* o, int vb0, bf16x8 pa0, bf16x8 pa1, bf16x8 pa2, bf16x8 pa3, bool act) {
    if (SK && !act) return;
#define TRRD(dst, off) asm volatile("ds_read_b64_tr_b16 %0, %1 offset:%2" : "=&v"(dst) : "v"(vb0), "i"(off) : "memory")
#define PV_D0(d0) do { s16x4 l0, l1, l2, l3, h0, h1, h2, h3; constexpr int b_ = VB * SHM_V + v_rd_off(d0, 0, 0);   \
        TRRD(l0, b_); TRRD(h0, b_ + 2048); TRRD(l1, b_ + 4096); TRRD(h1, b_ + 6144); TRRD(l2, b_ + 8192); TRRD(h2, b_ + 10240); TRRD(l3, b_ + 12288); TRRD(h3, b_ + 14336); \
        asm volatile("s_waitcnt lgkmcnt(0)" ::: "memory"); SBAR();                                                          \
        o[d0] = __builtin_amdgcn_mfma_f32_32x32x16_bf16(pa0, (bf16x8){l0[0], l0[1], l0[2], l0[3], h0[0], h0[1], h0[2], h0[3]}, o[d0], 0, 0, 0);   \
        o[d0] = __builtin_amdgcn_mfma_f32_32x32x16_bf16(pa1, (bf16x8){l1[0], l1[1], l1[2], l1[3], h1[0], h1[1], h1[2], h1[3]}, o[d0], 0, 0, 0);   \
        o[d0] = __builtin_amdgcn_mfma_f32_32x32x16_bf16(pa2, (bf16x8){l2[0], l2[1], l2[2], l2[3], h2[0], h2[1], h2[2], h2[3]}, o[d0], 0, 0, 0);   \
        o[d0] = __builtin_amdgcn_mfma_f32_32x32x16_bf16(pa3, (bf16x8){l3[0], l3[1], l3[2], l3[3], h3[0], h3[1], h3[2], h3[3]}, o[d0], 0, 0, 0); } while (0)
    PV_D0(0); PV_D0(1); PV_D0(2); PV_D0(3);
#undef PV_D0
#undef TRRD
}
struct BlockRef { const bf16* Q; const bf16* K; const bf16* V; bf16* O; const float* cum; float* lse; int P0, ld, ldo, lse_stride, skv, jlo; };
struct Seam { bf16x8 qr[8]; bf16x8 st_v0, st_v1, st_k0, st_k1; float st_b; int wave; };
__device__ __forceinline__ int swa_jlo(int P0, int W) { const int lowk = P0 - W + 1; return lowk > 0 ? lowk / KVBLK : 0; }
#define VMW() asm volatile("s_waitcnt vmcnt(0)" ::: "memory")
#define VMWN(n) asm volatile("s_waitcnt vmcnt(%0)" :: "i"(n) : "memory")
#define SLOAD_H(B_, k0) do { const bf16* vt_ = (B_).V + (size_t)(k0) * (B_).ld; const bf16* kt_ = (B_).K + (size_t)(k0) * (B_).ld;         \
                             const int o0_ = sr * (B_).ld + sc, o1_ = o0_ + 32 * (B_).ld;                                                     \
                             S.st_v0 = load8(vt_ + o0_); S.st_v1 = load8(vt_ + o1_); S.st_k0 = load8(kt_ + o0_); S.st_k1 = load8(kt_ + o1_);   \
                             if constexpr (FOX) { if (tid < 64) S.st_b = (B_).cum[(k0) + tid]; } } while (0)
#define SWRITE_HK(bf, cref_) do { *(bf16x8*)(K_lds + (bf) * SHM_K + kws) = S.st_k0; *(bf16x8*)(K_lds + (bf) * SHM_K + kws + 32 * 256) = S.st_k1;      \
                                  if constexpr (FOX) { if (tid < 64) bias_l[(bf) * 64 + tid] = ((cref_) - S.st_b) * (1.0f / SCALE); } } while (0)
#define SWRITE_HV(bf) do { *(bf16x8*)(V_lds + (bf) * SHM_V + vst0) = S.st_v0; *(bf16x8*)(V_lds + (bf) * SHM_V + vst1) = S.st_v1; } while (0)
#define SWRITE_H(bf, cref_) do { SWRITE_HV(bf); SWRITE_HK(bf, cref_); } while (0)
template <bool FOX, int LDC>
__device__ __forceinline__ void attn_prime(const BlockRef& cur_, int W, char* lds, Seam& S) {
    BlockRef cur = cur_; cur.ld = LDC;
    const int tid_ = S.wave * 64 + pg8::lane_id_now();
    const int tid = tid_, wid = __builtin_amdgcn_readfirstlane(S.wave), lane = tid & 63, r32 = lane & 31, hi = lane >> 5;
    const int sr = tid >> 4, sc = (tid & 15) * 8, kws = KSWZ(sr, sc * 2); char* K_lds = lds + 2 * SHM_V; float* bias_l = (float*)(lds + OFF_BIAS);
    __builtin_amdgcn_s_waitcnt(0);
    const int kb0 = (FOX ? cur.jlo : swa_jlo(cur.P0, W)) * KVBLK;
    float cref = 0.f; if constexpr (FOX) cref = cur.cum[cur.P0];
    { const bf16* qw_ = cur.Q + (size_t)(wid * QBLK) * cur.ld; const int qo_ = r32 * cur.ld + hi * 8;
      for (int d0 = 0; d0 < 8; ++d0) S.qr[d0] = load8(qw_ + qo_ + d0 * 16); }
    SLOAD_H(cur, kb0); VMW(); SWRITE_HK(0, cref);
    __syncthreads();
}
template <bool FOX, bool SK, bool LSE, int LDC, int LDOC>
__device__ __forceinline__ void attn_block(const BlockRef& cur_, const BlockRef& nxt_, int W, char* lds, Seam& S) {
    BlockRef cur = cur_, nxt = nxt_; cur.ld = LDC; nxt.ld = LDC; cur.ldo = LDOC;
    const int tid_ = S.wave * 64 + pg8::lane_id_now();
    const int tid = tid_, wid = __builtin_amdgcn_readfirstlane(S.wave), lane = tid & 63, r32 = lane & 31, hi = lane >> 5;
    const int j_lo = FOX ? cur.jlo : swa_jlo(cur.P0, W);
    int j_hi = (cur.P0 + QB - 1) / KVBLK + 1; if (j_hi > cur.skv / KVBLK) j_hi = cur.skv / KVBLK;
    const int NT = j_hi - j_lo;
    const int kbn = (FOX ? nxt.jlo : swa_jlo(nxt.P0, W)) * KVBLK;
    const int qlo = cur.P0 + wid * QBLK, qm = qlo + r32 - 4 * hi;
    char* V_lds = lds; char* K_lds = lds + 2 * SHM_V;
    float* ws = (float*)(lds + OFF_WS) + wid * 64; float* li_l = ws, * al_l = ws + 32; float* bias_l = (float*)(lds + OFF_BIAS);
    float m_reg = -1e30f, l_reg = 0; f32x16 o[4] = {};
    const int sr = tid >> 4, sc = (tid & 15) * 8, vst0 = v_st(sr, sc), vst1 = v_st(32 + sr, sc), kws = KSWZ(sr, sc * 2);
    const int vb0 = (int)(uintptr_t)V_lds + v_rd_base(lane);
    float cref = 0.f, crefn = 0.f; if constexpr (FOX) { cref = cur.cum[cur.P0]; crefn = nxt.cum[nxt.P0]; }
#define RESC(a) do { if (__any((a) < 1.f)) { if (hi == 0) al_l[r32] = (a); asm volatile("s_waitcnt lgkmcnt(0)" ::: "memory");              \
                     for (int d_ = 0; d_ < 4; ++d_) for (int r = 0; r < 16; ++r) o[d_][r] *= al_l[crow(r, hi)]; } } while (0)
#define KBASE(t) ((j_lo + (t)) * KVBLK)
#define ACT(t) (KBASE(t) <= qlo + QBLK - 1 && KBASE(t) + KVBLK - 1 >= qlo - W + 1)
#define MASKT(P0_, P1_, t) do { const int kb_ = KBASE(t); if ((!SK || ACT(t)) && (kb_ + KVBLK - 1 > qlo || kb_ <= qlo + QBLK - 1 - W)) mask_tile(P0_, P1_, qm - kb_, (unsigned)W); } while (0)
    constexpr int NQL = 8;
#define SEAM_K0() do { VMWN(NQL); SWRITE_HK(0, crefn); SBAR(); } while (0)
    f32x16 pA0, pA1, pB0, pB1; float mnA, mnB, alA, alB; bf16x8 pa0, pa1, pa2, pa3;
    SWRITE_HV(0); SBAR();
    if (NT > 1) { SLOAD_H(cur, KBASE(1)); }
    SBAR(); qkt<0, SK, FOX>(pA0, pA1, K_lds, r32, hi, S.qr, ACT(0), bias_l);
    MASKT(pA0, pA1, 0); partialSM<FOX>(pA0, pA1, m_reg, mnA, alA);
    if (NT > 1) { VMW(); SWRITE_H(1, cref); }
    __syncthreads();
#define HALF_STEP(PX0, PX1, mnX, alX, PY0, PY1, alY, t, KB, VB, SB) do {                                                      \
        SBAR(); qkt<KB, SK, FOX>(PX0, PX1, K_lds, r32, hi, S.qr, ACT(t), bias_l);                                             \
        finishSM(PY0, PY1, alY, l_reg, pa0, pa1, pa2, pa3); SBAR();                                                           \
        if ((t) + 1 < NT) { SLOAD_H(cur, KBASE((t) + 1)); SBAR(); }                                                             \
        pv_tile<VB, SK>(o, vb0, pa0, pa1, pa2, pa3, ACT((t) - 1)); MASKT(PX0, PX1, (t)); partialSM<FOX>(PX0, PX1, m_reg, mnX, alX);   \
        __syncthreads();                                                                                                      \
        if ((t) + 1 < NT) { VMW(); SWRITE_H(SB, cref); }                                                                      \
        RESC(alX); __syncthreads(); } while (0)
    for (int t = 1; t + 1 < NT; t += 2) {
        HALF_STEP(pB0, pB1, mnB, alB, pA0, pA1, alA, t, 1, 0, 0);
        HALF_STEP(pA0, pA1, mnA, alA, pB0, pB1, alB, t + 1, 0, 1, 1);
    }
    const bool even = (NT & 1) == 0;
    if (even) { SBAR(); qkt<1, SK, FOX>(pB0, pB1, K_lds, r32, hi, S.qr, ACT(NT - 1), bias_l); SBAR(); }
    SLOAD_H(nxt, kbn); SBAR();
    { const bf16* qw_ = nxt.Q + (size_t)(wid * QBLK) * nxt.ld; const int qo_ = r32 * nxt.ld + hi * 8;
#pragma unroll
      for (int d0 = 0; d0 < 8; ++d0) S.qr[d0] = load8(qw_ + qo_ + d0 * 16); }
    SBAR();
    finishSM(pA0, pA1, alA, l_reg, pa0, pa1, pa2, pa3); SBAR();
    pv_tile<0, SK>(o, vb0, pa0, pa1, pa2, pa3, ACT(even ? NT - 2 : NT - 1));
    if (even) { MASKT(pB0, pB1, NT - 1); partialSM<FOX>(pB0, pB1, m_reg, mnB, alB); __syncthreads(); RESC(alB);
        finishSM(pB0, pB1, alB, l_reg, pa0, pa1, pa2, pa3); SBAR(); pv_tile<1, SK>(o, vb0, pa0, pa1, pa2, pa3, ACT(NT - 1)); }
    SBAR(); SEAM_K0();
    if (hi == 0) li_l[r32] = l_reg; asm volatile("s_waitcnt lgkmcnt(0)" ::: "memory");
    if constexpr (LSE) { int ro_ = wid * QBLK + r32; asm volatile("" : "+v"(ro_));
        if (hi == 0) cur.lse[ro_ * cur.lse_stride] = m_reg * SCALE + __logf(l_reg); }
    float rli[16];
#pragma unroll
    for (int r = 0; r < 16; ++r) rli[r] = __builtin_amdgcn_rcpf(li_l[crow(r, hi)]);
    bf16* Ow = cur.O + (size_t)(wid * QBLK) * cur.ldo;
#pragma unroll
    for (int r = 0; r < 16; ++r) { const int orow = crow(r, hi);
#pragma unroll
        for (int d0 = 0; d0 < 4; ++d0) { const float v = o[d0][r] * rli[r];
            const float vn = pg8::dpp_mov<0xB1>(v);
            if ((r32 & 1) == 0) *(unsigned*)(Ow + (orow * cur.ldo + d0 * 32 + r32)) = cvtpk(v, vn); } }
    __syncthreads();
#undef RESC
#undef KBASE
#undef ACT
#undef MASKT
#undef SEAM_K0
#undef HALF_STEP
}
#undef VMW
#undef VMWN
#undef SLOAD_H
#undef SWRITE_HK
#undef SWRITE_HV
#undef SWRITE_H
}


constexpr int NWAVES = 8;
#ifndef WGM_FFN_IN
#define WGM_FFN_IN 4
#endif
#ifndef WGM_FFN_OUT
#define WGM_FFN_OUT 4
#endif
#ifndef WGM_P4_QK
#define WGM_P4_QK 8
#endif
#ifndef WGM_OTHER
#define WGM_OTHER 4
#endif
constexpr size_t MiB = 1u << 20;
constexpr size_t WS_CTL = 0, CTL_ZERO_BYTES = 1 * MiB;
constexpr size_t WS_ROPE = 1 * MiB;
constexpr size_t WS_WF = 5 * MiB;
constexpr size_t WS_LOGF = 6 * MiB, WS_CUM = 7 * MiB;
constexpr size_t WS_LSE = 8 * MiB;
constexpr size_t WS_NRM = 9 * MiB + 512 * 1024;
constexpr int NRM_QN_WORDS = 32 * 32 * 4, NRM_KN_WORDS = 32 * 128 * 4;
constexpr size_t WS_P = 10 * MiB;
constexpr size_t WS_W = 74 * MiB, W_LAYER = 201 * MiB;
constexpr size_t WO_W1 = 0, WO_W2 = 44 * MiB, WO_W3 = 66 * MiB, WO_WA = 112 * MiB, WO_WB = 116 * MiB, WO_WO = 118 * MiB, WO_W6 = 126 * MiB, WO_W7 = 170 * MiB, WO_WP = 192 * MiB, WO_WG = 193 * MiB;
constexpr size_t WS_U = 878 * MiB;
constexpr size_t WS_BIG = 1006 * MiB;
constexpr size_t B_QA = 0, B_KA = 64 * MiB, B_VA = 128 * MiB;
constexpr size_t B_QB = 192 * MiB, B_KB = 288 * MiB, B_VB = 384 * MiB;
constexpr size_t B_GA = 480 * MiB, B_GB = 608 * MiB;
constexpr size_t B_H = 0;
constexpr size_t B_Y = 352 * MiB;
#ifndef XRES_BF16
#define XRES_BF16 1
#endif
constexpr bool XB = XRES_BF16 != 0;
constexpr size_t B_XF = 128 * MiB;
constexpr size_t B_T = 64 * MiB;
constexpr size_t WS_END = 1742 * MiB;
constexpr int CW_BAR = 4096;
constexpr int CW_QUEUE = 8192;

constexpr int RING_OFF = 0, RING_BYTES = 131072;
constexpr int LDSCTL_OFF = RING_BYTES, MISC_OFF = LDSCTL_OFF + 320;
constexpr int LDS_BYTES = 147456;

__device__ const double INVF[64] = {
1.0, 0.8659643233600653, 0.7498942093324559, 0.6493816315762113,
0.5623413251903491, 0.4869675251658631, 0.4216965034285822, 0.3651741272548377,
0.31622776601683794, 0.27384196342643613, 0.23713737056616552, 0.2053525026457146,
0.1778279410038923, 0.1539926526059492, 0.1333521432163324, 0.11547819846894582,
0.1, 0.08659643233600653, 0.07498942093324558, 0.06493816315762113,
0.05623413251903491, 0.04869675251658631, 0.042169650342858224, 0.03651741272548377,
0.03162277660168379, 0.027384196342643614, 0.023713737056616554, 0.02053525026457146,
0.01778279410038923, 0.01539926526059492, 0.01333521432163324, 0.011547819846894581,
0.01, 0.008659643233600654, 0.007498942093324558, 0.006493816315762113,
0.005623413251903491, 0.004869675251658631, 0.004216965034285823, 0.003651741272548377,
0.0031622776601683794, 0.0027384196342643613, 0.0023713737056616554, 0.002053525026457146,
0.0017782794100389228, 0.001539926526059492, 0.001333521432163324, 0.0011547819846894581,
0.001, 0.0008659643233600654, 0.0007498942093324559, 0.0006493816315762113,
0.0005623413251903491, 0.0004869675251658631, 0.00042169650342858224, 0.0003651741272548377,
0.00031622776601683794, 0.0002738419634264361, 0.00023713737056616554, 0.0002053525026457146,
0.00017782794100389227, 0.0001539926526059492, 0.0001333521432163324, 0.00011547819846894582};

struct Frame {
    LAS unsigned char* lds;
    volatile LAS unsigned* MISC;
    int tid, lane, wave, vcu, G;
    unsigned char* ws;
};
__device__ __forceinline__ float wave_sum(float v) { return pg8::xrow_sum(pg8::row16_sum(v)); }

__device__ __forceinline__ void tr_item(const float* W, int ldw, int c_src, int k0, bf16* dst, int K  , LAS float* scr, int lane) {
#pragma unroll
    for (int i = 0; i < 32; ++i) { const int kk = 2 * i + (lane >> 5); scr[kk * 33 + (lane & 31)] = __builtin_nontemporal_load(W + (size_t)(k0 + kk) * ldw + c_src + (lane & 31)); }
    LDS_WAIT(); asm volatile("" ::: "memory");
    const int c = lane & 7;
#pragma unroll
    for (int j = 0; j < 4; ++j) { const int n = (lane >> 3) + 8 * j; const LAS float* s = scr + (8 * c) * 33 + n;
        v4u o; o.x = pk2(s[0 * 33], s[1 * 33]); o.y = pk2(s[2 * 33], s[3 * 33]); o.z = pk2(s[4 * 33], s[5 * 33]); o.w = pk2(s[6 * 33], s[7 * 33]);
        __builtin_nontemporal_store(o, (v4u*)(dst + (size_t)n * K + k0 + 8 * c)); }
    LDS_WAIT(); asm volatile("" ::: "memory");
}
constexpr int I_W1 = (DM / 64) * (2 * DFF / 32), I_W2 = (DFF / 64) * (DM / 32), I_W3 = (DM / 64) * 368, I_WA = (1024 / 64) * (DM / 32), I_WB = (512 / 64) * (DM / 32),
              I_WO = (DM / 64) * (DM / 32), I_WP = (PLE / 64) * (DM / 32), I_LAYER = 2 * I_W1 + 2 * I_W2 + I_W3 + I_WA + I_WB + 2 * I_WO + I_WP;
struct In { const float *x, *p, *norm_g, *ffn1_in, *ffn1_out, *mix_in, *fox_b, *br_a, *br_b, *mix_out, *ffn2_in, *ffn2_out, *ple_proj, *ple_gate; };

__device__ __forceinline__ void tr_swiglu(const float* W, bf16* WT, int r, LAS float* scr, int lane) {
    const int nb = r % 352, kb = r / 352, c0 = 32 * nb, part = c0 >= DFF ? 1 : 0, cp = c0 - part * DFF;
    const int drow = 256 * (cp / 128) + 128 * part + (cp % 128);
    tr_item(W, 2 * DFF, c0, 64 * kb, WT + (size_t)drow * DM, DM, scr, lane);
}
__device__ __forceinline__ void tr_plain(const float* W, int K, int N, bf16* WT, int r, LAS float* scr, int lane, int pitch = 0, int koff = 0, bool tiled = false) {
    const int nblk = N / 32, nb = r % nblk, kb = r / nblk, P = pitch ? pitch : K;
    if (tiled) tr_item(W, N, 32 * nb, 64 * kb, WT + ((size_t)((32 * nb) >> 8) * (K / 64) + kb) * 16384 + ((32 * nb) & 255) * 64 - 64 * kb, 64, scr, lane);
    else tr_item(W, N, 32 * nb, 64 * kb, WT + (size_t)(32 * nb) * P + koff, P, scr, lane);
}
__device__ __forceinline__ void tr_mix(const float* W, bf16* WT, int r, LAS float* scr, int lane) {
    const int nb = r % 368, kb = r / 368; int c_src, drow;
    if (nb < 96) { c_src = 32 * nb; drow = 32 * nb; }
    else if (nb < 240) { const int cc0 = 32 * (nb - 96); c_src = C_QB + cc0;
        if (cc0 < 3072) { const int t = cc0 / 1536, cq = cc0 % 1536, head = cq / 128, bj = (cq % 128) / 64, dd0 = cq % 64;
            drow = 3072 + 1536 * t + 256 * (head >> 1) + 128 * bj + 64 * (head & 1) + dd0; }
        else drow = 3072 + cc0; }
    else { const int cc0 = 32 * (nb - 240), part = cc0 >= 2048 ? 1 : 0, cp = cc0 - part * 2048; c_src = C_GA + cc0; drow = 7680 + 256 * (cp / 128) + 128 * part + (cp % 128); }
    tr_item(W, NCOLS, c_src, 64 * kb, WT + (size_t)drow * DM, DM, scr, lane);
}
__device__ __forceinline__ void sincos_d(double x, float& s, float& c) {
    const double q = __builtin_rint(x * 0.63661977236758134308);
    double r = __builtin_fma(-q, 1.5707963267948966192, x); r = __builtin_fma(-q, 6.123233995736766036e-17, r);
    const double r2 = r * r;
    double sp = -7.6471637318198164759e-13; sp = sp * r2 + 1.6059043836821614599e-10; sp = sp * r2 - 2.5052108385441718775e-08; sp = sp * r2 + 2.7557319223985890653e-06;
    sp = sp * r2 - 1.9841269841269841270e-04; sp = sp * r2 + 8.3333333333333333333e-03; sp = sp * r2 - 1.6666666666666666667e-01; const double sn = r + r * r2 * sp;
    double cp = 4.7794773323873852974e-14; cp = cp * r2 - 1.1470745597729724714e-11; cp = cp * r2 + 2.0876756987868098979e-09; cp = cp * r2 - 2.7557319223985890653e-07;
    cp = cp * r2 + 2.4801587301587301587e-05; cp = cp * r2 - 1.3888888888888888889e-03; cp = cp * r2 + 4.1666666666666666667e-02; cp = cp * r2 - 0.5; const double cs = 1.0 + r2 * cp;
    const int n = ((int)q) & 3;
    const double so = (n == 0) ? sn : (n == 1) ? cs : (n == 2) ? -sn : -cs;
    const double co = (n == 0) ? cs : (n == 1) ? -sn : (n == 2) ? -cs : sn;
    s = (float)so; c = (float)co;
}
__device__ __forceinline__ void p_prologue(Frame& F, const In& in) {
    LAS float* scr = (LAS float*)(F.lds + RING_OFF + F.wave * 16384);
    const int gw = F.vcu * NWAVES + F.wave, NGW = F.G * NWAVES;
    for (int it = gw; it < DEPTH * I_LAYER; it += NGW) {
        const int L = it / I_LAYER; int r = it - L * I_LAYER; unsigned char* wl = F.ws + WS_W + (size_t)L * W_LAYER;
        if (r < I_W1) { tr_swiglu(in.ffn1_in + (size_t)L * DM * 2 * DFF, (bf16*)(wl + WO_W1), r, scr, F.lane); continue; } r -= I_W1;
        if (r < I_W2) { tr_plain(in.ffn1_out + (size_t)L * DFF * DM, DFF, DM, (bf16*)(wl + WO_W2), r, scr, F.lane, 0, 0, true); continue; } r -= I_W2;
        if (r < I_W3) { tr_mix(in.mix_in + (size_t)L * DM * NCOLS, (bf16*)(wl + WO_W3), r, scr, F.lane); continue; } r -= I_W3;
        if (r < I_WA) { tr_plain(in.br_a + (size_t)L * 1024 * DM, 1024, DM, (bf16*)(wl + WO_WA), r, scr, F.lane, 1536, 0); continue; } r -= I_WA;
        if (r < I_WB) { tr_plain(in.br_b + (size_t)L * 512 * DM, 512, DM, (bf16*)(wl + WO_WA), r, scr, F.lane, 1536, 1024); continue; } r -= I_WB;
        if (r < I_WO) { tr_plain(in.mix_out + (size_t)L * DM * DM, DM, DM, (bf16*)(wl + WO_WO), r, scr, F.lane); continue; } r -= I_WO;
        if (r < I_W1) { tr_swiglu(in.ffn2_in + (size_t)L * DM * 2 * DFF, (bf16*)(wl + WO_W6), r, scr, F.lane); continue; } r -= I_W1;
        if (r < I_W2) { tr_plain(in.ffn2_out + (size_t)L * DFF * DM, DFF, DM, (bf16*)(wl + WO_W7), r, scr, F.lane, 0, 0, true); continue; } r -= I_W2;
        if (r < I_WP) { tr_plain(in.ple_proj + (size_t)L * PLE * DM, PLE, DM, (bf16*)(wl + WO_WP), r, scr, F.lane); continue; } r -= I_WP;
        tr_plain(in.ple_gate + (size_t)L * DM * DM, DM, DM, (bf16*)(wl + WO_WG), r, scr, F.lane);
    }
    const size_t gt = (size_t)blockIdx.x * 512 + F.tid, NT = (size_t)F.G * 512;
    { const f32x4* ps = (const f32x4*)in.p; v4u* pd = (v4u*)(F.ws + WS_P);
      for (size_t i = gt; i < (size_t)DEPTH * M * PLE / 8; i += NT) { const f32x4 a = __builtin_nontemporal_load(ps + 2 * i), b = __builtin_nontemporal_load(ps + 2 * i + 1);
          v4u o; o.x = pk2(a[0], a[1]); o.y = pk2(a[2], a[3]); o.z = pk2(b[0], b[1]); o.w = pk2(b[2], b[3]); pd[i] = o; } }
    { float* ct = (float*)(F.ws + WS_ROPE); float* st = ct + SEQ * 64;
      for (size_t i = gt; i < (size_t)SEQ * 64; i += NT) { const int t = (int)(i >> 6), dd = (int)(i & 63); float s, c; sincos_d((double)t * INVF[dd], s, c); ct[i] = c; st[i] = s; } }
    { float* wf = (float*)(F.ws + WS_WF);
      for (size_t i = gt; i < (size_t)DEPTH * 8 * DM; i += NT) { const int L = (int)(i / (8 * DM)), h = (int)((i / DM) & 7), k = (int)(i % DM);
          wf[i] = in.mix_in[((size_t)L * DM + k) * NCOLS + C_F + h]; } }
}

template <bool WITH_F, bool HAS_Y, bool HAS_U, bool Y_BF16, bool WRITE_X = true, bool XIN_BF16 = false, bool XOUT_BF16 = false>
__device__ __forceinline__ void norm_pass(Frame& F, const void* xin, const void* y, float coef, const float* gpost, const float* gpre, void* xout, bf16* U, const float* bfox, float* logf) {
    const int gw = F.vcu * NWAVES + F.wave, NGW = F.G * NWAVES;
    const LAS f32x4* wfl = (const LAS f32x4*)(F.lds + RING_OFF);
    LAS f32x4* gl = (LAS f32x4*)(F.lds + RING_OFF + 65536);
    { const int i_ = F.tid, pd = (2 * (i_ >> 7) + (i_ & 1)) * 64 + ((i_ & 127) >> 1);
      if (HAS_Y) gl[pd] = ((const f32x4*)gpost)[i_];
      if (HAS_U) gl[512 + pd] = ((const f32x4*)gpre)[i_]; }
    LDS_WAIT(); __syncthreads();
    typedef unsigned long long u64;
    f32x4 rxf[8]; v4u rxb[4]; f32x4 ryf[8]; v4u ryb[4];
#define NP_ISSUE(R) do { \
        if constexpr (XIN_BF16) { const v4u* xr_ = (const v4u*)((const bf16*)xin + (size_t)(R) * DM) + F.lane; \
            _Pragma("unroll") for (int j = 0; j < 4; ++j) rxb[j] = __builtin_nontemporal_load(xr_ + 64 * j); } \
        else { const f32x4* xr_ = (const f32x4*)((const float*)xin + (size_t)(R) * DM) + 2 * F.lane; \
            _Pragma("unroll") for (int j = 0; j < 8; ++j) rxf[j] = __builtin_nontemporal_load(xr_ + 128 * (j >> 1) + (j & 1)); } \
        if constexpr (HAS_Y) { \
            if constexpr (Y_BF16) { const v4u* yr_ = (const v4u*)((const bf16*)y + (size_t)(R) * DM) + F.lane; \
                _Pragma("unroll") for (int j = 0; j < 4; ++j) ryb[j] = __builtin_nontemporal_load(yr_ + 64 * j); } \
            else { const f32x4* yr_ = (const f32x4*)((const float*)y + (size_t)(R) * DM) + 2 * F.lane; \
                _Pragma("unroll") for (int j = 0; j < 8; ++j) ryf[j] = __builtin_nontemporal_load(yr_ + 128 * (j >> 1) + (j & 1)); } } } while (0)
    if (gw < M) NP_ISSUE(gw);
    for (int row = gw; row < M; row += NGW) {
        f32x4 xv[8];
#pragma unroll
        for (int j = 0; j < 8; ++j) {
            if constexpr (XIN_BF16) { const unsigned lo = (j & 1) ? rxb[j >> 1].z : rxb[j >> 1].x, hi = (j & 1) ? rxb[j >> 1].w : rxb[j >> 1].y;
                xv[j] = (f32x4){__uint_as_float(lo << 16), __uint_as_float(lo & 0xffff0000u), __uint_as_float(hi << 16), __uint_as_float(hi & 0xffff0000u)}; }
            else xv[j] = rxf[j]; }
        f32x4 yv[8];
        if constexpr (HAS_Y) {
#pragma unroll
            for (int j = 0; j < 8; ++j) {
                if constexpr (Y_BF16) { const unsigned lo = (j & 1) ? ryb[j >> 1].z : ryb[j >> 1].x, hi = (j & 1) ? ryb[j >> 1].w : ryb[j >> 1].y;
                    yv[j] = (f32x4){__uint_as_float(lo << 16), __uint_as_float(lo & 0xffff0000u), __uint_as_float(hi << 16), __uint_as_float(hi & 0xffff0000u)}; }
                else yv[j] = ryf[j]; } }
        { const int nrow = row + NGW; if (nrow < M) NP_ISSUE(nrow); }
        if (HAS_Y) {
            float ss = 0.f;
#pragma unroll
            for (int j = 0; j < 8; ++j) { ss += (yv[j][0] * yv[j][0] + yv[j][1] * yv[j][1]) + (yv[j][2] * yv[j][2] + yv[j][3] * yv[j][3]); }
            const float ry = coef / sqrtf(wave_sum(ss) * (1.f / DM) + RMS_EPS);
#pragma unroll
            for (int j = 0; j < 8; ++j) { const f32x4 g = gl[F.lane + 64 * j]; xv[j] += yv[j] * ry * g; }
        }
        if constexpr (WRITE_X) {
            if constexpr (XOUT_BF16) { v4u* xo = (v4u*)((bf16*)xout + (size_t)row * DM) + F.lane;
#pragma unroll
                for (int j = 0; j < 4; ++j) { v4u o; o.x = pk2(xv[2 * j][0], xv[2 * j][1]); o.y = pk2(xv[2 * j][2], xv[2 * j][3]); o.z = pk2(xv[2 * j + 1][0], xv[2 * j + 1][1]); o.w = pk2(xv[2 * j + 1][2], xv[2 * j + 1][3]);
                    __builtin_nontemporal_store(o, xo + 64 * j); } }
            else { f32x4* xo = (f32x4*)((float*)xout + (size_t)row * DM) + 2 * F.lane;
#pragma unroll
                for (int j = 0; j < 8; ++j) __builtin_nontemporal_store(xv[j], xo + 128 * (j >> 1) + (j & 1)); } }
        if (HAS_U) {
            float ss = 0.f;
#pragma unroll
            for (int j = 0; j < 8; ++j) ss += (xv[j][0] * xv[j][0] + xv[j][1] * xv[j][1]) + (xv[j][2] * xv[j][2] + xv[j][3] * xv[j][3]);
            const float rx = 1.f / sqrtf(wave_sum(ss) * (1.f / DM) + RMS_EPS);
            v4u* uo = (v4u*)(U + (size_t)row * DM) + F.lane;
#pragma unroll
            for (int j = 0; j < 8; ++j) { const f32x4 g = gl[512 + F.lane + 64 * j]; xv[j] = xv[j] * rx * g; }
#pragma unroll
            for (int j = 0; j < 4; ++j) { v4u o; o.x = pk2(xv[2 * j][0], xv[2 * j][1]); o.y = pk2(xv[2 * j][2], xv[2 * j][3]); o.z = pk2(xv[2 * j + 1][0], xv[2 * j + 1][1]); o.w = pk2(xv[2 * j + 1][2], xv[2 * j + 1][3]);
                uo[64 * j] = o; }
            if (WITH_F) {
                float mine = 0.f;
#pragma unroll 1
                for (int h = 0; h < 8; ++h) { float a = 0.f;
#pragma unroll
                    for (int j = 0; j < 8; ++j) { const f32x4 w = wfl[h * 512 + F.lane + 64 * j]; a += (xv[j][0] * w[0] + xv[j][1] * w[1]) + (xv[j][2] * w[2] + xv[j][3] * w[3]); }
                    a = wave_sum(a); mine = (F.lane == h) ? a : mine; }
                if (F.lane < 8) { const float v = mine + bfox[F.lane];
                    const float e = __builtin_amdgcn_exp2f(-1.4426950408889634f * fabsf(v));
                    const float l1p = (e < 0.03f) ? e * (1.f - e * (0.5f - e * (0.33333333f - e * 0.25f))) : 0.6931471805599453f * __builtin_amdgcn_logf(1.f + e);
                    const float ls = fminf(v, 0.f) - l1p;
                    const int b = row / SEQ, t = row - b * SEQ; logf[(size_t)(b * 8 + F.lane) * SEQ + t] = ls; }
            }
        }
    }
}
#undef NP_ISSUE
__device__ __forceinline__ void scan_phase(Frame& F, int bid) {
    LAS double* tot = (LAS double*)(F.lds + RING_OFF); LAS double* offp = tot + NWAVES * 64; LAS double* wsum = offp + NWAVES * 64;
    if (F.G == 256) {
        const int s = bid >> 3, j = bid & 7;
        const float* lf = (const float*)(F.ws + WS_LOGF) + (size_t)s * SEQ; float* cs = (float*)(F.ws + WS_CUM) + (size_t)s * SEQ;
        const float a0 = lf[1024 * j + 2 * F.tid], a1 = lf[1024 * j + 2 * F.tid + 1];
        double po = 0.0;
        { float tv[14];
#pragma unroll
          for (int k = 0; k < 14; ++k) tv[k] = (k < 2 * j) ? lf[F.tid + 512 * k] : 0.f;
#pragma unroll
          for (int k = 0; k < 14; ++k) po += (double)tv[k]; }
        tot[F.tid] = (double)a0 + (double)a1; offp[F.tid] = po;
        LDS_WAIT(); __syncthreads();
        double wt = 0.0, wo = 0.0, pre = 0.0;
        for (int i = 0; i < 64; ++i) { const double t = tot[F.wave * 64 + i], o = offp[F.wave * 64 + i]; wt += t; wo += o; pre += (i < F.lane) ? t : 0.0; }
        if (F.lane == 0) { wsum[F.wave] = wt; wsum[8 + F.wave] = wo; }
        LDS_WAIT(); __syncthreads();
        double base = pre;
        for (int w = 0; w < NWAVES; ++w) { base += wsum[8 + w]; base += (w < F.wave) ? wsum[w] : 0.0; }
        const double c0 = base + (double)a0, c1 = c0 + (double)a1;
        typedef float f32x2v __attribute__((ext_vector_type(2)));
        *(f32x2v*)(cs + 1024 * j + 2 * F.tid) = (f32x2v){(float)c0, (float)c1};
        __syncthreads();
        return;
    }
    if (bid >= 32) return;
    const float* lf = (const float*)(F.ws + WS_LOGF) + (size_t)bid * SEQ; float* cs = (float*)(F.ws + WS_CUM) + (size_t)bid * SEQ;
    f32x4 v[4]; double run = 0.0; double pre[16];
#pragma unroll
    for (int j = 0; j < 4; ++j) v[j] = ((const f32x4*)lf)[F.tid * 4 + j];
#pragma unroll
    for (int j = 0; j < 4; ++j)
#pragma unroll
        for (int e = 0; e < 4; ++e) { run += (double)v[j][e]; pre[4 * j + e] = run; }
    tot[F.tid] = run;
    LDS_WAIT(); __syncthreads();
    double base = 0.0;
    for (int i = 0; i < NWAVES * 64; ++i) { const double v = tot[i]; base += (i < F.tid) ? v : 0.0; }
#pragma unroll
    for (int j = 0; j < 4; ++j) { f32x4 o;
#pragma unroll
        for (int e = 0; e < 4; ++e) o[e] = (float)(base + pre[4 * j + e]);
        ((f32x4*)cs)[F.tid * 4 + j] = o; }
    __syncthreads();
}
__device__ __forceinline__ void combine_phase(Frame& F) {
    const int gw = F.vcu * NWAVES + F.wave, NGW = F.G * NWAVES;
    const float* lse = (const float*)(F.ws + WS_LSE); const bf16* og = (const bf16*)(F.ws + WS_BIG + B_QB); bf16* ob = (bf16*)(F.ws + WS_U);
    const int j = F.lane >> 4, d8 = (F.lane & 15) * 8;
    for (int tok0 = gw; tok0 < M; tok0 += 2 * NGW) {
        const int tok1 = (tok0 + NGW < M) ? tok0 + NGW : tok0;
        float l[2][3]; v4u raw[2][3];
#pragma unroll
        for (int q = 0; q < 2; ++q) { const int tok = q ? tok1 : tok0; const bf16* r = og + (size_t)tok * 1536 + j * 128 + d8;
#pragma unroll
            for (int g = 0; g < 3; ++g) { l[q][g] = lse[((size_t)g * M + tok) * 4 + j]; raw[q][g] = __builtin_nontemporal_load((const v4u*)(r + 512 * g)); } }
#pragma unroll
        for (int q = 0; q < 2; ++q) { const int tok = q ? tok1 : tok0;
            const float mx = fmaxf(l[q][0], fmaxf(l[q][1], l[q][2])); const float e0 = expf(l[q][0] - mx), e1 = expf(l[q][1] - mx), e2 = expf(l[q][2] - mx), inv = 1.f / (e0 + e1 + e2);
            f32x4 a0, a1, b0, b1, c0, c1; pg8::unpack8(raw[q][0], a0, a1); pg8::unpack8(raw[q][1], b0, b1); pg8::unpack8(raw[q][2], c0, c1);
            const float w0 = e0 * inv, w1 = e1 * inv, w2 = e2 * inv;
            *(v4u*)(ob + (size_t)tok * 1536 + 1024 + j * 128 + d8) = pg8::pack8(a0 * w0 + b0 * w1 + c0 * w2, a1 * w0 + b1 * w1 + c1 * w2); }
    }
}

__device__ __forceinline__ att::BlockRef fox_ref(unsigned char* ws, int n) {
    const int qb = 31 - (n >> 5), bh = n & 31, b = bh >> 3, h = bh & 7; const size_t base = (size_t)b * SEQ * 1024 + h * 128;
    att::BlockRef r; r.Q = (const bf16*)(ws + WS_BIG + B_QA) + base + (size_t)qb * 256 * 1024; r.K = (const bf16*)(ws + WS_BIG + B_KA) + base; r.V = (const bf16*)(ws + WS_BIG + B_VA) + base;
    r.O = (bf16*)(ws + WS_U) + ((size_t)b * SEQ + (size_t)qb * 256) * 1536 + h * 128; r.ldo = 1536;
    r.cum = (const float*)(ws + WS_CUM) + (size_t)bh * SEQ; r.lse = nullptr; r.P0 = qb * 256; r.ld = 1024; r.lse_stride = 0; r.skv = SEQ;
    const int l_ = pg8::lane_id_now();
    unsigned* qn = (unsigned*)(ws + WS_NRM) + (bh * 32 + qb) * 4; unsigned* kn = (unsigned*)(ws + WS_NRM) + NRM_QN_WORDS + bh * 128 * 4;
    float q2 = 0.f, ka = 0.f, kb = 0.f;
#pragma unroll
    for (int i = 0; i < 4; ++i) { q2 += __uint_as_float(__hip_atomic_load(qn + i, __ATOMIC_RELAXED, __HIP_MEMORY_SCOPE_AGENT));
        ka += __uint_as_float(__hip_atomic_load(kn + l_ * 4 + i, __ATOMIC_RELAXED, __HIP_MEMORY_SCOPE_AGENT)); kb += __uint_as_float(__hip_atomic_load(kn + (l_ + 64) * 4 + i, __ATOMIC_RELAXED, __HIP_MEMORY_SCOPE_AGENT)); }
    float kd = 0.f;
#pragma unroll
    for (int i = 0; i < 4; ++i) { const int d = 4 * qb + i; const float v = __uint_as_float((d < 64) ? __builtin_amdgcn_readlane(__float_as_uint(ka), d & 63) : __builtin_amdgcn_readlane(__float_as_uint(kb), d & 63)); kd = fmaxf(kd, v); }
    const float SC = ATT_SCALE * 1.01f, Ts = sqrtf(q2 * kd) * SC + 26.f, Ta = Ts + sqrtf(q2 * ka) * SC, Tb = Ts + sqrtf(q2 * kb) * SC;
    const float c0 = r.cum[r.P0];
    int k0 = 64 * l_ + 63, k1 = k0 + 4096; if (k0 > r.P0) k0 = r.P0; if (k1 > r.P0) k1 = r.P0;
    const unsigned long long m0 = __ballot((r.cum[k0] - c0) < Ta), m1 = __ballot((r.cum[k1] - c0) < Tb);
    r.jlo = m0 ? __builtin_ctzll(m0) : (m1 ? 64 + __builtin_ctzll(m1) : 0);
    return r;
}
template <int G_IDX>
__device__ __forceinline__ att::BlockRef dil_ref(unsigned char* ws, int r_) {
    constexpr int g = G_IDX, d = (g == 0) ? 1 : (g == 1) ? 4 : 16, nqb = 32 / d, ld = d * 1536;
    const int seq = r_ / nqb, qb = r_ % nqb, b = seq / (4 * d), j = (seq / d) & 3, res = seq % d, head = 4 * g + j;
    const size_t off = ((size_t)b * SEQ + res) * 1536 + head * 128;
    att::BlockRef r; r.Q = (const bf16*)(ws + WS_BIG + B_QB) + off + (size_t)qb * 256 * ld; r.K = (const bf16*)(ws + WS_BIG + B_KB) + off; r.V = (const bf16*)(ws + WS_BIG + B_VB) + off;
    r.O = const_cast<bf16*>(r.Q); r.cum = nullptr; r.lse = (float*)(ws + WS_LSE) + ((size_t)g * M + (size_t)b * SEQ + res + (size_t)qb * 256 * d) * 4 + j; r.P0 = qb * 256; r.ld = ld; r.ldo = ld; r.lse_stride = d * 4; r.skv = SEQ / d; return r;
}
template <int G_IDX>
__device__ __forceinline__ void dil_stream(Frame& F, char* ldsg, unsigned* qhead, att::Seam& S) {
    constexpr int d = (G_IDX == 0) ? 1 : (G_IDX == 1) ? 4 : 16, LD = d * 1536; const int W = 129;
    volatile LAS int* slot = (volatile LAS int*)(F.lds + RING_OFF + att::OFF_QSLOT);
    const int tid_ = F.wave * 64 + pg8::lane_id_now();
    if (tid_ == 0) { slot[0] = (int)__hip_atomic_fetch_add(qhead, 1u, __ATOMIC_RELAXED, __HIP_MEMORY_SCOPE_AGENT); slot[1] = (int)__hip_atomic_fetch_add(qhead, 1u, __ATOMIC_RELAXED, __HIP_MEMORY_SCOPE_AGENT); }
    __syncthreads();
    int n_cur = __builtin_amdgcn_readfirstlane(slot[0]), n_nxt = __builtin_amdgcn_readfirstlane(slot[1]);
    __syncthreads();
    if (n_cur >= 512) return;
    att::BlockRef cur = dil_ref<G_IDX>(F.ws, n_cur);
    att::attn_prime<false, LD>(cur, W, ldsg, S);
    for (;;) { const bool last = n_nxt >= 512; const att::BlockRef nxt = last ? cur : dil_ref<G_IDX>(F.ws, n_nxt);
        att::attn_block<false, true, true, LD, LD>(cur, nxt, W, ldsg, S);
        if (last) break;
        if (tid_ == 0) slot[0] = (int)__hip_atomic_fetch_add(qhead, 1u, __ATOMIC_RELAXED, __HIP_MEMORY_SCOPE_AGENT);
        __syncthreads();
        const int nn = __builtin_amdgcn_readfirstlane(slot[0]);
        cur = nxt; n_cur = n_nxt; n_nxt = nn; }
}
__device__ __forceinline__ void attn_phase(Frame& F, char* ldsg, int bid, int G, int layer) {
    att::Seam S; S.wave = F.wave;
    {
        unsigned* qhead = (unsigned*)(F.ws + WS_CTL) + CW_QUEUE + 64 * layer; volatile LAS int* slot = (volatile LAS int*)(F.lds + RING_OFF + att::OFF_QSLOT);
        const int W = 1 << 30; const int tid_ = F.wave * 64 + pg8::lane_id_now();
        if (tid_ == 0) { slot[0] = (int)__hip_atomic_fetch_add(qhead, 1u, __ATOMIC_RELAXED, __HIP_MEMORY_SCOPE_AGENT); slot[1] = (int)__hip_atomic_fetch_add(qhead, 1u, __ATOMIC_RELAXED, __HIP_MEMORY_SCOPE_AGENT); }
        __syncthreads();
        int n_cur = __builtin_amdgcn_readfirstlane(slot[0]), n_nxt = __builtin_amdgcn_readfirstlane(slot[1]);
        __syncthreads();
        if (n_cur < 1024) {
            att::BlockRef cur = fox_ref(F.ws, n_cur);
            att::attn_prime<true, 1024>(cur, W, ldsg, S);
            for (;;) { const bool last = n_nxt >= 1024;
                const att::BlockRef nxt = last ? cur : fox_ref(F.ws, n_nxt);
                int g_ = 0; if (!last && tid_ == 0) g_ = (int)__hip_atomic_fetch_add(qhead, 1u, __ATOMIC_RELAXED, __HIP_MEMORY_SCOPE_AGENT);
                att::attn_block<true, false, false, 1024, 1536>(cur, nxt, W, ldsg, S);
                if (last) break;
                if (tid_ == 0) slot[0] = g_;
                __syncthreads();
                const int nn = __builtin_amdgcn_readfirstlane(slot[0]);
                cur = nxt; n_cur = n_nxt; n_nxt = nn; }
        }
    }
    { unsigned* qd = (unsigned*)(F.ws + WS_CTL) + CW_QUEUE + 64 * (4 + 3 * layer); (void)bid; (void)G;
      dil_stream<0>(F, ldsg, qd, S); dil_stream<1>(F, ldsg, qd + 64, S); dil_stream<2>(F, ldsg, qd + 128, S); }
}

#if MK_NAIVE_ATTN
__global__ __launch_bounds__(256) void naive_attn(unsigned char* ws, int mode) {
    __shared__ __attribute__((aligned(16))) bf16 Kt[64 * 128];
    __shared__ __attribute__((aligned(16))) bf16 Vt[64 * 128];
    __shared__ float biasl[64];
    const int tid = threadIdx.x, qi = tid >> 2, part = tid & 3;
    const bf16 *Q, *K, *V; float* lse = nullptr; const float* cum = nullptr; int pitch, W, P0, lstride = 0;
    if (mode == 0) { const int it = blockIdx.x, qb = 127 - it / 32, s = it % 32, b = s >> 3, h = s & 7; const size_t off = (size_t)b * SEQ * 1024 + h * 128;
        Q = (const bf16*)(ws + WS_BIG + B_QA) + off; K = (const bf16*)(ws + WS_BIG + B_KA) + off; V = (const bf16*)(ws + WS_BIG + B_VA) + off; pitch = 1024; W = 1 << 30; P0 = qb * 64;
        cum = (const float*)(ws + WS_CUM) + (size_t)s * SEQ; }
    else { const int it = blockIdx.x, g = it / 2048, r = it % 2048, d = (g == 0) ? 1 : (g == 1) ? 4 : 16, L = SEQ / d, nqb = L / 64, seq = r / nqb, qb = r % nqb;
        const int b = seq / (4 * d), j = (seq / d) & 3, res = seq % d, head = 4 * g + j; const size_t off = ((size_t)b * SEQ + res) * 1536 + head * 128;
        Q = (const bf16*)(ws + WS_BIG + B_QB) + off; K = (const bf16*)(ws + WS_BIG + B_KB) + off; V = (const bf16*)(ws + WS_BIG + B_VB) + off; pitch = d * 1536; W = 129; P0 = qb * 64;
        lse = (float*)(ws + WS_LSE) + ((size_t)g * M + (size_t)b * SEQ + res) * 4 + j; lstride = d * 4; }
    const int i = P0 + qi;
    float q[32], o[32];
    { const v4u* qp = (const v4u*)(Q + (size_t)i * pitch + 32 * part);
#pragma unroll
      for (int c = 0; c < 4; ++c) { f32x4 a, b; pg8::unpack8(qp[c], a, b);
#pragma unroll
          for (int e = 0; e < 4; ++e) { q[8 * c + e] = a[e]; q[8 * c + 4 + e] = b[e]; } } }
#pragma unroll
    for (int e = 0; e < 32; ++e) o[e] = 0.f;
    const float ci = cum ? cum[i] : 0.f;
    float m = -1e30f, l = 0.f;
    int jstart = P0 - (W - 1); if (jstart < 0 || W > SEQ) jstart = 0; jstart &= ~63;
    for (int j0 = jstart; j0 < P0 + 64; j0 += 64) {
        __syncthreads();
#pragma unroll
        for (int c = 0; c < 4; ++c) { const int idx = tid + 256 * c, row = idx >> 4, ch = idx & 15;
            *(v4u*)(Kt + row * 128 + ch * 8) = *(const v4u*)(K + (size_t)(j0 + row) * pitch + ch * 8);
            *(v4u*)(Vt + row * 128 + ch * 8) = *(const v4u*)(V + (size_t)(j0 + row) * pitch + ch * 8); }
        if (cum && tid < 64) biasl[tid] = cum[j0 + tid];
        __syncthreads();
        for (int kk0 = 0; kk0 < 64; kk0 += 8) {
            float s[8]; float cmax = -__builtin_inff();
#pragma unroll
            for (int e = 0; e < 8; ++e) { const int kk = kk0 + e; const v4u* kp = (const v4u*)(Kt + kk * 128 + 32 * part); float dot = 0.f;
#pragma unroll
                for (int c = 0; c < 4; ++c) { f32x4 a, b; pg8::unpack8(kp[c], a, b);
#pragma unroll
                    for (int x = 0; x < 4; ++x) dot += q[8 * c + x] * a[x] + q[8 * c + 4 + x] * b[x]; }
                dot += __shfl_xor(dot, 1); dot += __shfl_xor(dot, 2);
                const int jj = j0 + kk; const bool valid = (jj <= i) && (i - jj < W);
                float sc = dot * ATT_SCALE; if (cum) sc += ci - biasl[kk];
                s[e] = valid ? sc : -__builtin_inff(); cmax = fmaxf(cmax, s[e]); }
            const float mn = fmaxf(m, cmax), alpha = expf(m - mn); m = mn; l *= alpha;
#pragma unroll
            for (int e = 0; e < 32; ++e) o[e] *= alpha;
#pragma unroll
            for (int e = 0; e < 8; ++e) { const float p = expf(s[e] - mn); l += p; const v4u* vp = (const v4u*)(Vt + (kk0 + e) * 128 + 32 * part);
#pragma unroll
                for (int c = 0; c < 4; ++c) { f32x4 a, b; pg8::unpack8(vp[c], a, b);
#pragma unroll
                    for (int x = 0; x < 4; ++x) { o[8 * c + x] += p * a[x]; o[8 * c + 4 + x] += p * b[x]; } } }
        }
    }
    const float inv = 1.f / l;
    { v4u* op = (v4u*)(const_cast<bf16*>(Q) + (size_t)i * pitch + 32 * part);
#pragma unroll
      for (int c = 0; c < 4; ++c) op[c] = pg8::pack8((f32x4){o[8 * c] * inv, o[8 * c + 1] * inv, o[8 * c + 2] * inv, o[8 * c + 3] * inv}, (f32x4){o[8 * c + 4] * inv, o[8 * c + 5] * inv, o[8 * c + 6] * inv, o[8 * c + 7] * inv}); }
    if (lse && part == 0) lse[(size_t)i * lstride] = m + logf(l);
}

#endif
constexpr int NPH_LAYER = 14, PH_TOTAL = 2 + DEPTH * NPH_LAYER;
struct Args { const float* in[14]; float* out; unsigned char* ws; int lo, hi; };
__global__ void __launch_bounds__(NWAVES * 64, 2) fwd(Args args) {
    extern __shared__ __attribute__((aligned(16))) unsigned char lds[];
    Frame F;
    F.lds = (LAS unsigned char*)lds; F.MISC = (volatile LAS unsigned*)(F.lds + MISC_OFF);
    F.tid = threadIdx.x; F.lane = F.tid & 63; F.wave = __builtin_amdgcn_readfirstlane(F.tid >> 6);
    F.G = gridDim.x; { const int bx = blockIdx.x; F.vcu = (F.G % 8 == 0) ? (bx % 8) * (F.G / 8) + bx / 8 : bx; }
    F.ws = args.ws;
    In in; in.x = args.in[0]; in.p = args.in[1]; in.norm_g = args.in[2]; in.ffn1_in = args.in[3]; in.ffn1_out = args.in[4]; in.mix_in = args.in[5]; in.fox_b = args.in[6]; in.br_a = args.in[7];
    in.br_b = args.in[8]; in.mix_out = args.in[9]; in.ffn2_in = args.in[10]; in.ffn2_out = args.in[11]; in.ple_proj = args.in[12]; in.ple_gate = args.in[13];
    for (int u = F.tid; u < (LDS_BYTES - LDSCTL_OFF) / 4; u += NWAVES * 64) ((LAS unsigned*)(F.lds + LDSCTL_OFF))[u] = 0u;
    __syncthreads();
    XcdBarrier bar = xcd_barrier_post((unsigned*)(F.ws + WS_CTL) + CW_BAR, F.MISC + 8); bar.wave = F.wave;
#define IN(k) (lo <= (k) && (k) < hi)
#ifndef PH_MASK
#define PH_MASK 0xffff
#endif
#define PHM(k) (((PH_MASK) >> (k)) & 1)
#define REFRESH_TID() do { const int l_ = pg8::lane_id_now(); F.lane = l_; F.tid = F.wave * 64 + l_; } while (0)
#define SEAM(k) do { if (IN(k) && IN((k) + 1)) xcd_barrier(bar); } while (0)
    LAS unsigned char* const ring = F.lds + RING_OFF;

    { const int lo = args.lo, hi = args.hi; if (PHM(14) && IN(0)) { p_prologue(F, in); SEAM(0); } }

    for (int L = 0; L < DEPTH; ++L) {
        size_t z_ = 0; int lo = args.lo, hi = args.hi;
        asm volatile("" : "+s"(z_), "+s"(lo), "+s"(hi));
        unsigned char* ws_ = args.ws + z_; float* out_ = args.out + z_; const float* ng_ = args.in[2] + z_; const float* fb_ = args.in[6] + z_;
        F.ws = ws_; in.norm_g = ng_; in.fox_b = fb_;
        unsigned char* const big = F.ws + WS_BIG; bf16* const U = (bf16*)(F.ws + WS_U); float* const Y = (float*)(big + B_Y); void* const xres = (void*)out_;
        REFRESH_TID();
        int bid_ = blockIdx.x, G_ = gridDim.x; asm volatile("" : "+s"(bid_), "+s"(G_));
        F.G = G_; F.vcu = (G_ % 8 == 0) ? (bid_ % 8) * (G_ / 8) + bid_ / 8 : bid_;
        const int pb = 1 + NPH_LAYER * L; unsigned char* const wl = F.ws + WS_W + (size_t)L * W_LAYER; const float* const g = in.norm_g + (size_t)L * 8 * DM;
        if (PHM(0) && IN(pb + 0)) { REFRESH_TID();
            if (L == 0) norm_pass<false, false, true, false, XB, false, XB>(F, in.x, nullptr, 0.f, nullptr, g + 0 * DM, xres, U, nullptr, nullptr);
            else norm_pass<false, true, true, true, true, XB, XB>(F, xres, Y, 1.f, g - 8 * DM + 7 * DM, g + 0 * DM, xres, U, nullptr, nullptr);
            SEAM(pb + 0); }
        if (PHM(1) && IN(pb + 1)) { pg8::Gemm gm{U, (const bf16*)(wl + WO_W1), M, 2 * DFF, DM}; gm.wave = F.wave; pg8::StaticOrder S; S.init(M, 2 * DFF, F.G, bid_, WGM_FFN_IN);
            pg8::EpiSwiGLU E{(bf16*)(big + B_H), DFF}; pg8::gemm_phase<pg8::EpiSwiGLU, pg8::StaticOrder, true, true>(ring, gm, S, E); SEAM(pb + 1); }
        if (PHM(2) && IN(pb + 2)) { pg8::Gemm gm{(const bf16*)(big + B_H), (const bf16*)(wl + WO_W2), M, DM, DFF}; gm.wave = F.wave; gm.a_tiled = 1; gm.b_tiled = 1; pg8::StaticOrder S; S.init(M, DM, F.G, bid_, WGM_FFN_OUT);
            pg8::EpiSplitBf16<0> E{(bf16*)Y, DM, 0, 0}; pg8::gemm_phase<pg8::EpiSplitBf16<0>, pg8::StaticOrder, true, true>(ring, gm, S, E); SEAM(pb + 2); }
        if (PHM(3) && IN(pb + 3)) { REFRESH_TID();
            { const f32x4* wf4 = (const f32x4*)((const float*)(F.ws + WS_WF) + (size_t)L * 8 * DM); LAS f32x4* wl4 = (LAS f32x4*)ring;
              f32x4 t_[8];
#pragma unroll
              for (int j = 0; j < 8; ++j) t_[j] = wf4[F.tid + 512 * j];
#pragma unroll
              for (int j = 0; j < 8; ++j) { const int f4 = F.tid;
                  wl4[j * 512 + (2 * (f4 >> 7) + (f4 & 1)) * 64 + ((f4 & 127) >> 1)] = t_[j]; }
              LDS_WAIT(); __syncthreads(); }
            for (int i = bid_ * (NWAVES * 64) + F.tid; i < NRM_QN_WORDS + NRM_KN_WORDS; i += F.G * (NWAVES * 64)) ((unsigned*)(F.ws + WS_NRM))[i] = 0u;
            norm_pass<true, true, true, true, true, XB, XB>(F, (!XB && L == 0) ? (const void*)in.x : (const void*)xres, Y, 0.5f, g + 1 * DM, g + 2 * DM, xres, U, in.fox_b + L * 8, (float*)(F.ws + WS_LOGF));
            SEAM(pb + 3); }
        if (PHM(4) && IN(pb + 4)) {
#ifndef P4MASK
#define P4MASK 31
#endif
            if (P4MASK & 16) { REFRESH_TID(); scan_phase(F, bid_); }
            const bf16* W3 = (const bf16*)(wl + WO_W3);
            if (P4MASK & 1) { pg8::Gemm gm{U, W3, M, 3072, DM}; gm.wave = F.wave; pg8::StaticOrder S; S.init(M, 3072, F.G, bid_, WGM_P4_QK);
              pg8::EpiFoxQKV E{(bf16*)(big + B_QA), (unsigned*)(F.ws + WS_NRM), (unsigned*)(F.ws + WS_NRM) + NRM_QN_WORDS}; pg8::gemm_phase<pg8::EpiFoxQKV, pg8::StaticOrder, true, true>(ring, gm, S, E); }
            if (P4MASK & 2) { pg8::Gemm gm{U, W3 + (size_t)3072 * DM, M, 3072, DM}; gm.wave = F.wave; pg8::StaticOrder S; S.init(M, 3072, F.G, bid_, WGM_P4_QK);
              pg8::EpiRope E{(bf16*)(big + B_QB), (bf16*)(big + B_KB), (const float*)(F.ws + WS_ROPE), (const float*)(F.ws + WS_ROPE) + SEQ * 64}; pg8::gemm_phase<pg8::EpiRope, pg8::StaticOrder, true, true>(ring, gm, S, E); }
            if (P4MASK & 4) { pg8::Gemm gm{U, W3 + (size_t)6144 * DM, M, 1536, DM}; gm.wave = F.wave; pg8::StaticOrder S; S.init(M, 1536, F.G, bid_, WGM_P4_QK);
              pg8::EpiSplitBf16<0> E{(bf16*)(big + B_VB), 1536, 0, 0}; pg8::gemm_phase<pg8::EpiSplitBf16<0>, pg8::StaticOrder, true, true>(ring, gm, S, E); }
            if (P4MASK & 8) { pg8::Gemm gm{U, W3 + (size_t)7680 * DM, M, 4096, DM}; gm.wave = F.wave; pg8::StaticOrder S; S.init(M, 4096, F.G, bid_, WGM_OTHER);
              pg8::EpiGates E{(bf16*)(big + B_GA), (bf16*)(big + B_GB)}; pg8::gemm_phase<pg8::EpiGates, pg8::StaticOrder, true, true>(ring, gm, S, E); }
            SEAM(pb + 4); }
#if !MK_NAIVE_ATTN
        if (PHM(5) && IN(pb + 5)) { attn_phase(F, (char*)lds, bid_, G_, L); SEAM(pb + 5); }
#else
        if (PHM(5) && IN(pb + 5)) { SEAM(pb + 5); }
#endif
        if (PHM(6) && IN(pb + 6)) { REFRESH_TID(); combine_phase(F); SEAM(pb + 6); }
        if (PHM(7) && IN(pb + 7)) {
            { pg8::Gemm gm{(const bf16*)(F.ws + WS_U), (const bf16*)(wl + WO_WA), M, DM, 1536}; gm.wave = F.wave; pg8::StaticOrder S; S.init(M, DM, F.G, bid_, WGM_OTHER);
              pg8::EpiMixOut E{(const bf16*)(big + B_GA), (const bf16*)(big + B_GB), (bf16*)(big + B_T)}; pg8::gemm_phase<pg8::EpiMixOut, pg8::StaticOrder, true, true>(ring, gm, S, E); }
            SEAM(pb + 7); }
        if (PHM(8) && IN(pb + 8)) { pg8::Gemm gm{(const bf16*)(big + B_T), (const bf16*)(wl + WO_WO), M, DM, DM}; gm.wave = F.wave; pg8::StaticOrder S; S.init(M, DM, F.G, bid_, WGM_OTHER);
            pg8::EpiSplitBf16<0> E{(bf16*)Y, DM, 0, 0}; pg8::gemm_phase<pg8::EpiSplitBf16<0>, pg8::StaticOrder, true, true>(ring, gm, S, E); SEAM(pb + 8); }
        if (PHM(9) && IN(pb + 9)) { REFRESH_TID(); norm_pass<false, true, true, true, true, XB, XB>(F, xres, Y, 1.f, g + 3 * DM, g + 4 * DM, xres, U, nullptr, nullptr); SEAM(pb + 9); }
        if (PHM(10) && IN(pb + 10)) { pg8::Gemm gm{U, (const bf16*)(wl + WO_W6), M, 2 * DFF, DM}; gm.wave = F.wave; pg8::StaticOrder S; S.init(M, 2 * DFF, F.G, bid_, WGM_FFN_IN);
            pg8::EpiSwiGLU E{(bf16*)(big + B_H), DFF}; pg8::gemm_phase<pg8::EpiSwiGLU, pg8::StaticOrder, true, true>(ring, gm, S, E); SEAM(pb + 10); }
        if (PHM(11) && IN(pb + 11)) { pg8::Gemm gm{(const bf16*)(big + B_H), (const bf16*)(wl + WO_W7), M, DM, DFF}; gm.wave = F.wave; gm.a_tiled = 1; gm.b_tiled = 1; pg8::StaticOrder S; S.init(M, DM, F.G, bid_, WGM_FFN_OUT);
            pg8::EpiSplitBf16<0> E{(bf16*)Y, DM, 0, 0}; pg8::gemm_phase<pg8::EpiSplitBf16<0>, pg8::StaticOrder, true, true>(ring, gm, S, E); SEAM(pb + 11); }
        if (PHM(12) && IN(pb + 12)) { REFRESH_TID(); norm_pass<false, true, true, true, true, XB, XB>(F, xres, Y, 0.5f, g + 5 * DM, g + 6 * DM, (XB && L == DEPTH - 1) ? (void*)(big + B_XF) : xres, U, nullptr, nullptr); SEAM(pb + 12); }
        if (PHM(13) && IN(pb + 13)) {
            { pg8::Gemm gm{(const bf16*)(F.ws + WS_P) + (size_t)L * M * PLE, (const bf16*)(wl + WO_WP), M, DM, PLE}; gm.wave = F.wave; pg8::StaticOrder S; S.init(M, DM, F.G, bid_, WGM_OTHER);
              pg8::EpiSplitBf16<0> E{(bf16*)(big + B_H), DM, 0, 0}; pg8::gemm_phase<pg8::EpiSplitBf16<0>, pg8::StaticOrder, true, true>(ring, gm, S, E); }
            { pg8::Gemm gm{U, (const bf16*)(wl + WO_WG), M, DM, DM}; gm.wave = F.wave; pg8::StaticOrder S; S.init(M, DM, F.G, bid_, WGM_OTHER);
              pg8::EpiPle E{(const bf16*)(big + B_H), (bf16*)Y}; pg8::gemm_phase<pg8::EpiPle, pg8::StaticOrder, true, true>(ring, gm, S, E); }
            SEAM(pb + 13); }
    }
    { size_t z_ = 0; int lo = args.lo, hi = args.hi; asm volatile("" : "+s"(z_), "+s"(lo), "+s"(hi)); REFRESH_TID();
      { int bid_ = blockIdx.x, G_ = gridDim.x; asm volatile("" : "+s"(bid_), "+s"(G_)); F.G = G_; F.vcu = (G_ % 8 == 0) ? (bid_ % 8) * (G_ / 8) + bid_ / 8 : bid_; }
      float* const xres = args.out + z_; float* const Y = (float*)(args.ws + z_ + WS_BIG + B_Y); const bf16* const xfin = (const bf16*)(args.ws + z_ + WS_BIG + B_XF); F.ws = args.ws + z_; in.norm_g = args.in[2] + z_;
    if (PHM(15) && IN(PH_TOTAL - 1)) norm_pass<false, true, false, true, true, XB, false>(F, XB ? (const void*)xfin : (const void*)xres, Y, 1.f, in.norm_g + (size_t)(DEPTH - 1) * 8 * DM + 7 * DM, nullptr, xres, nullptr, nullptr, nullptr); }
#undef IN
#undef SEAM
}

#ifdef DUMP_OFF
__global__ void dump_fold(const unsigned short* src, size_t n, float* out, size_t nout) {
    for (size_t i = (size_t)blockIdx.x * blockDim.x + threadIdx.x; i < nout; i += (size_t)gridDim.x * blockDim.x) {
        float s = 0.f; for (size_t k = i; k < n; k += nout) { const unsigned short v = src[k]; const unsigned short e = (v >> 7) & 0xff; const float f = (e == 0xff) ? 12345.f : __uint_as_float(((unsigned)v) << 16); s += f; }
        out[i] = s; }
}
#endif
extern "C" void kernel_launch(void* const* d_in, const int* in_sizes, int n_in, void* d_out, int out_size, void* d_ws, size_t ws_size, hipStream_t stream) {
    static int grid = 0;
    if (grid == 0) {
        if (n_in != 14 || in_sizes[0] != M * DM || out_size != M * DM || ws_size < WS_END) { fprintf(stderr, "kernel_launch: unexpected shapes / workspace (n_in %d, ws %zu < %zu); nothing launched\n", n_in, ws_size, (size_t)WS_END); grid = -1; return; }
        int dev = 0, cus = 0;
        if (hipGetDevice(&dev) != hipSuccess || hipDeviceGetAttribute(&cus, hipDeviceAttributeMultiprocessorCount, dev) != hipSuccess) { grid = -1; return; }
        if (hipFuncSetAttribute((const void*)fwd, hipFuncAttributeMaxDynamicSharedMemorySize, LDS_BYTES) != hipSuccess) { fprintf(stderr, "kernel_launch: hipFuncSetAttribute failed\n"); grid = -1; return; }
        int per_cu = 0; (void)hipOccupancyMaxActiveBlocksPerMultiprocessor(&per_cu, (const void*)fwd, NWAVES * 64, LDS_BYTES); (void)hipGetLastError();
        grid = cus;
    }
    if (grid < 0) return;
    (void)hipMemsetAsync((char*)d_ws + WS_CTL, 0, CTL_ZERO_BYTES, stream);
    Args a{};
    for (int i = 0; i < 14; ++i) a.in[i] = (const float*)d_in[i];
    a.out = (float*)d_out; a.ws = (unsigned char*)d_ws;
#if MK_BRINGUP
#ifndef STOP_AT
#define STOP_AT PH_TOTAL
#endif
    for (int ph = 0; ph < STOP_AT; ++ph) {
        const int p = (ph >= 1 && ph < PH_TOTAL - 1) ? (ph - 1) % NPH_LAYER : -1;
#if MK_NAIVE_ATTN
        if (p == 5) { hipLaunchKernelGGL(naive_attn, dim3(4096), dim3(256), 0, stream, (unsigned char*)d_ws, 0); hipLaunchKernelGGL(naive_attn, dim3(6144), dim3(256), 0, stream, (unsigned char*)d_ws, 1); continue; }
#endif
        (void)p;
        a.lo = ph; a.hi = ph + 1;
        hipLaunchKernelGGL(fwd, dim3(grid), dim3(NWAVES * 64), LDS_BYTES, stream, a);
    }
#ifdef DUMP_OFF
    hipLaunchKernelGGL(dump_fold, dim3(2048), dim3(256), 0, stream, (const unsigned short*)((unsigned char*)d_ws + (size_t)(DUMP_OFF)), (size_t)(DUMP_N), (float*)d_out, (size_t)M * DM);
#endif
#else
    a.lo = 0; a.hi = PH_TOTAL;
    hipLaunchKernelGGL(fwd, dim3(grid), dim3(NWAVES * 64), LDS_BYTES, stream, a);
#endif
}
```
